# Optimizing an MI355X kernel written in HIP

```python
import jax, jax.numpy as jnp
from jax import lax
import numpy as np

D_MODEL = 1024
BATCH = 2
SEQ = 8192
DEPTH = 2

CTX_LEN = 256
GRID_W = 64
W_CONV = D_MODEL
W_LRU = D_MODEL
LRU_BLOCKS = 8
LRU_BW = W_LRU // LRU_BLOCKS
CONV_A_WIDTH = 3
CONV_B_WIDTH = 4
LRU_C = 8.0
RMS_EPS = 1e-6
PROJ_WIDTHS = (W_CONV, W_CONV, W_CONV, W_CONV, W_LRU, W_LRU, D_MODEL, D_MODEL)
SPLIT_POINTS = tuple(int(v) for v in np.cumsum(PROJ_WIDTHS)[:-1])
D_IN = int(sum(PROJ_WIDTHS))

kernel_name = "hybrid_shortconv_rglru_dit_block"


def rmsnorm(x, g):
    xf = x.astype(jnp.float32)
    y = xf * lax.rsqrt(jnp.mean(xf * xf, axis=-1, keepdims=True) + RMS_EPS)
    return (y * g.astype(jnp.float32)).astype(x.dtype)


def dwconv(v, w, pad_left):
    k = w.shape[0]
    n = v.shape[-2]
    pad = [(0, 0)] * (v.ndim - 2) + [(pad_left, k - 1 - pad_left), (0, 0)]
    vp = jnp.pad(v, pad)
    out = w[0] * lax.slice_in_dim(vp, 0, n, axis=v.ndim - 2)
    for j in range(1, k):
        out = out + w[j] * lax.slice_in_dim(vp, j, j + n, axis=v.ndim - 2)
    return out


def grid_conv(v, w, pad_left):
    b, n, ch = v.shape
    rows = n // GRID_W
    return dwconv(v.reshape(b, rows, GRID_W, ch), w, pad_left).reshape(b, n, ch)


def block_diag(x, w, bias):
    xb = x.reshape(x.shape[:-1] + (LRU_BLOCKS, LRU_BW))
    y = jnp.einsum("blnk,nkj->blnj", xb, w)
    return y.reshape(x.shape) + bias


def _combine(lhs, rhs):
    a1, b1 = lhs
    a2, b2 = rhs
    return a1 * a2, a2 * b1 + b2


def linear_scan(a, u, h0, reverse):
    if reverse:
        a = jnp.flip(a, axis=1)
        u = jnp.flip(u, axis=1)
    u = u.at[:, 0].add(a[:, 0] * h0)
    _, h = lax.associative_scan(_combine, (a, u), axis=1)
    if reverse:
        h = jnp.flip(h, axis=1)
    return h


def rglru_direction(xc, h0, wr, br, wi, bi, lam, reverse):
    r = jax.nn.sigmoid(block_diag(xc, wr, br).astype(jnp.float32))
    i = jax.nn.sigmoid(block_diag(xc, wi, bi).astype(jnp.float32))
    log_a = -LRU_C * r * jax.nn.softplus(-lam.astype(jnp.float32))
    a = jnp.exp(log_a)
    mult = jnp.sqrt(-jnp.expm1(2.0 * log_a))
    u = mult * i * xc.astype(jnp.float32)
    h = linear_scan(a, u, h0, reverse)
    final = h[:, 0] if reverse else h[:, -1]
    return h, final


def bidir_rglru(xc, h0s, wr, br, wi, bi, lam):
    h_f, fin_f = rglru_direction(xc, h0s[0], wr[0], br[0], wi[0], bi[0], lam[0], False)
    h_b, fin_b = rglru_direction(xc, h0s[1], wr[1], br[1], wi[1], bi[1], lam[1], True)
    return (h_f + h_b).astype(xc.dtype), (fin_f, fin_b)


def gated_merge(chunks, y_lru, conv_fn, conv3_w, w_out_a, w_out_b, w_o):
    v, g_b, g_c, z_a, _, z_b, m_a, m_b = chunks
    y_a = g_b * conv_fn(g_c * v, conv3_w, 1) * jax.nn.silu(z_a)
    y_b = y_lru * jax.nn.silu(z_b)
    merged = jax.nn.sigmoid(m_a) * (y_a @ w_out_a) + jax.nn.sigmoid(m_b) * (y_b @ w_out_b)
    return merged @ w_o


def setup_inputs(seed: int = 0) -> dict:
    key = jax.random.key(seed)
    ks = jax.random.split(key, 20)
    f32 = jnp.float32
    nrm = lambda k, shape, s: jax.random.normal(k, shape, f32) * s
    x = nrm(ks[0], (BATCH, SEQ, D_MODEL), 1.0)
    c = nrm(ks[1], (BATCH, D_MODEL), 1.0)
    ctx = nrm(ks[2], (BATCH, CTX_LEN, D_MODEL), 1.0)
    c_ctx = nrm(ks[3], (D_MODEL,), 1.0)
    w_ada = nrm(ks[4], (DEPTH, D_MODEL, 3 * D_MODEL), D_MODEL ** -0.5)
    b_ada = nrm(ks[5], (DEPTH, 3 * D_MODEL), 0.02)
    norm_g = 1.0 + nrm(ks[6], (DEPTH, D_MODEL), 0.05)
    w_in = nrm(ks[7], (DEPTH, D_MODEL, D_IN), D_MODEL ** -0.5)
    conv3_w = nrm(ks[8], (DEPTH, CONV_A_WIDTH, W_CONV), CONV_A_WIDTH ** -0.5)
    conv4_w = nrm(ks[9], (DEPTH, CONV_B_WIDTH, W_LRU), CONV_B_WIDTH ** -0.5)
    conv4_b = nrm(ks[10], (DEPTH, W_LRU), 0.02)
    lru_wr = nrm(ks[11], (DEPTH, 2, LRU_BLOCKS, LRU_BW, LRU_BW), LRU_BW ** -0.5)
    lru_br = nrm(ks[12], (DEPTH, 2, W_LRU), 0.02)
    lru_wi = nrm(ks[13], (DEPTH, 2, LRU_BLOCKS, LRU_BW, LRU_BW), LRU_BW ** -0.5)
    lru_bi = nrm(ks[14], (DEPTH, 2, W_LRU), 0.02)
    a_pow = jax.random.uniform(ks[15], (DEPTH, 2, W_LRU), f32, 0.9, 0.999)
    base = a_pow ** (1.0 / LRU_C)
    lru_lambda = jnp.log(base) - jnp.log1p(-base)
    w_out_a = nrm(ks[16], (DEPTH, W_CONV, D_MODEL), W_CONV ** -0.5)
    w_out_b = nrm(ks[17], (DEPTH, W_LRU, D_MODEL), W_LRU ** -0.5)
    w_o = nrm(ks[18], (DEPTH, D_MODEL, D_MODEL), D_MODEL ** -0.5)
    final_g = 1.0 + nrm(ks[19], (D_MODEL,), 0.05)
    return {"x": x, "c": c, "ctx": ctx, "c_ctx": c_ctx, "w_ada": w_ada, "b_ada": b_ada,
            "norm_g": norm_g, "w_in": w_in, "conv3_w": conv3_w, "conv4_w": conv4_w,
            "conv4_b": conv4_b, "lru_wr": lru_wr, "lru_br": lru_br, "lru_wi": lru_wi,
            "lru_bi": lru_bi, "lru_lambda": lru_lambda, "w_out_a": w_out_a,
            "w_out_b": w_out_b, "w_o": w_o, "final_g": final_g}


def reference(x, c, ctx, c_ctx, w_ada, b_ada, norm_g, w_in, conv3_w, conv4_w, conv4_b,
              lru_wr, lru_br, lru_wi, lru_bi, lru_lambda, w_out_a, w_out_b, w_o, final_g):
    n_batch = x.shape[0]
    silu_c = jax.nn.silu(c)
    silu_cc = jax.nn.silu(c_ctx)
    for l in range(DEPTH):
        last = l == DEPTH - 1
        shift, scale, gate = jnp.split(silu_c @ w_ada[l] + b_ada[l], 3, axis=-1)
        shift_c, scale_c, gate_c = jnp.split(silu_cc @ w_ada[l] + b_ada[l], 3, axis=-1)
        h = rmsnorm(x, norm_g[l]) * (1.0 + scale[:, None]) + shift[:, None]
        hc = rmsnorm(ctx, norm_g[l]) * (1.0 + scale_c) + shift_c
        chunks = jnp.split(h @ w_in[l], SPLIT_POINTS, axis=-1)
        chunks_c = jnp.split(hc @ w_in[l], SPLIT_POINTS, axis=-1)
        lru_p = (lru_wr[l], lru_br[l], lru_wi[l], lru_bi[l], lru_lambda[l])
        xc_c = dwconv(chunks_c[4], conv4_w[l], 2) + conv4_b[l]
        zeros = jnp.zeros((n_batch, W_LRU), jnp.float32)
        y_lru_c, finals = bidir_rglru(xc_c, (zeros, zeros), *lru_p)
        xc = grid_conv(chunks[4], conv4_w[l], 2) + conv4_b[l]
        y_lru, _ = bidir_rglru(xc, finals, *lru_p)
        x = x + gate[:, None] * gated_merge(chunks, y_lru, grid_conv, conv3_w[l],
                                            w_out_a[l], w_out_b[l], w_o[l])
        if not last:
            ctx = ctx + gate_c * gated_merge(chunks_c, y_lru_c, dwconv, conv3_w[l],
                                             w_out_a[l], w_out_b[l], w_o[l])
    return rmsnorm(x, final_g)
```

```cpp
#include <hip/hip_runtime.h>
#include <cstdio>
#include <cstdint>

#ifndef MK_PER_PHASE
#define MK_PER_PHASE 0
#endif

#define LAS __attribute__((address_space(3)))
#define GAS __attribute__((address_space(1)))
typedef unsigned short bf16_t;
typedef short bf16x8 __attribute__((ext_vector_type(8)));
typedef float f32x4 __attribute__((ext_vector_type(4)));
typedef float f32x2 __attribute__((ext_vector_type(2)));
typedef unsigned u32x4 __attribute__((ext_vector_type(4)));
typedef unsigned u32x2 __attribute__((ext_vector_type(2)));
typedef GAS unsigned gu32;

constexpr int D = 1024, NB = 2, T = 8192, CT = 256, NL = 2, DIN = 8192;
constexpr int ML = NB * T;
constexpr int MC = NB * CT;
constexpr int M = ML + MC;
constexpr float RMS_EPS = 1e-6f;
constexpr float LOG2E = 1.4426950408889634f;

constexpr size_t MiB = 1u << 20;
constexpr size_t WS_CTL = 0, CTL_ZERO_BYTES = 1 * MiB;
constexpr size_t WS_MOD = 1 * MiB;
constexpr size_t WS_CLAM = WS_MOD + 128 * 1024;
constexpr size_t WS_AGG = WS_CLAM + 64 * 1024;
constexpr size_t WS_CARRY = WS_AGG + 1088 * 1024;
constexpr size_t WS_CTX1 = 4 * MiB;
constexpr size_t WS_W1T = 6 * MiB;
constexpr size_t WS_WABT = 38 * MiB;
constexpr size_t WS_WOT = 46 * MiB;
constexpr size_t WS_GWT = 50 * MiB;
constexpr size_t WS_BIG = 52 * MiB;
constexpr size_t WS_XC = 118 * MiB;
constexpr size_t WS_SZB = 151 * MiB;
constexpr size_t WS_RAT = 184 * MiB;
constexpr size_t WS_SMB = 217 * MiB;
constexpr size_t WS_END = 250 * MiB;
static_assert(WS_CARRY + 66 * 2 * 1024 * 4 <= WS_CTX1, "ws map");
static_assert((size_t)M * 1024 * 2 == 33 * MiB, "ws map");

constexpr int CW_BAR = 4096;

constexpr int RING_BYTES = 131072;
constexpr int MISC_OFF = RING_BYTES;
constexpr int SCR_OFF = RING_BYTES + 512;
constexpr int LDS_BYTES = 147456;
constexpr int NWAVES = 8;

__device__ __forceinline__ unsigned cvt_pk_bf16(float lo, float hi) { unsigned r; asm volatile("v_cvt_pk_bf16_f32 %0, %1, %2" : "=v"(r) : "v"(lo), "v"(hi)); return r; }
__device__ __forceinline__ float bf_lo(unsigned w) { return __uint_as_float(w << 16); }
__device__ __forceinline__ float bf_hi(unsigned w) { return __uint_as_float(w & 0xffff0000u); }
__device__ __forceinline__ f32x4 unpack4(u32x2 w) { return (f32x4){bf_lo(w.x), bf_hi(w.x), bf_lo(w.y), bf_hi(w.y)}; }
__device__ __forceinline__ u32x2 pack4(f32x4 v) { u32x2 w; w.x = cvt_pk_bf16(v[0], v[1]); w.y = cvt_pk_bf16(v[2], v[3]); return w; }
__device__ __forceinline__ float sigmoidf_(float x) { return __builtin_amdgcn_rcpf(1.0f + __builtin_amdgcn_exp2f(-x * LOG2E)); }
__device__ __forceinline__ f32x4 sigmoid4(f32x4 x) { return (f32x4){sigmoidf_(x[0]), sigmoidf_(x[1]), sigmoidf_(x[2]), sigmoidf_(x[3])}; }
__device__ __forceinline__ f32x4 silu4(f32x4 x) { return x * sigmoid4(x); }
template <int CTRL> __device__ __forceinline__ float dppf(float old, float src) {
    return __builtin_bit_cast(float, __builtin_amdgcn_update_dpp(__builtin_bit_cast(int, old), __builtin_bit_cast(int, src), CTRL, 0xf, 0xf, false));
}
template <int CTRL> __device__ __forceinline__ f32x4 dpp4(f32x4 old, f32x4 s) { return (f32x4){dppf<CTRL>(old[0], s[0]), dppf<CTRL>(old[1], s[1]), dppf<CTRL>(old[2], s[2]), dppf<CTRL>(old[3], s[3])}; }
#define DPP_ROR(n) (0x120 + (n))
#define DPP_SHR(n) (0x110 + (n))
#define DPP_SHL(n) (0x100 + (n))
#define DPP_BCAST(n) (0x150 + (n))
__device__ __forceinline__ f32x4 sel4(bool c, f32x4 a, f32x4 b) { return c ? a : b; }
__device__ __forceinline__ int fresh_lane() { unsigned z; asm volatile("s_mov_b32 %0, 0" : "=s"(z)); return (int)__builtin_amdgcn_mbcnt_hi(~0u, __builtin_amdgcn_mbcnt_lo(~0u, z)); }
#define LDS_WAIT() asm volatile("s_waitcnt lgkmcnt(0)" ::: "memory")
#define VM_WAIT() asm volatile("s_waitcnt vmcnt(0)" ::: "memory")
#define WG_BAR() do { asm volatile("s_waitcnt lgkmcnt(0)" ::: "memory"); __builtin_amdgcn_s_barrier(); asm volatile("" ::: "memory"); } while (0)

namespace pg8 {
constexpr int BM = 256, BK = 64, HALF = 128, HTB = HALF * BK * 2, STAGE_BYTES = 8 * HTB, NXCD = 8, WGM = 8;
__host__ __device__ __forceinline__ int lds_byte(int r, int c) { const int st = (r >> 4) * 2 + (c >> 5), rr = r & 15, cc = c & 31, ob = rr * 64 + cc * 2; return st * 1024 + (ob ^ (((ob >> 9) & 1) << 5)); }
__host__ __device__ __forceinline__ void stage_rc(int b, int& R, int& C) { const int st = b / 1024, sb = b % 1024, swz = sb ^ (((sb >> 9) & 1) << 5); R = (st >> 1) * 16 + swz / 64; C = (st & 1) * 32 + (swz % 64) / 2; }

struct Unit { int pm, pn, kk; };
struct Gemm {
    const bf16_t* A; const bf16_t* Bt; int lda, ldb, K; int a_kk, b_kk; int a_pn_shift, a_pn_mul;
    __device__ __forceinline__ const char* a_ptr(const Unit& u) const { return (const char*)(A + (size_t)u.pm * 256 * lda + (size_t)u.kk * a_kk + (size_t)(u.pn >> a_pn_shift) * a_pn_mul); }
    __device__ __forceinline__ const char* b_ptr(const Unit& u) const { return (const char*)(Bt + (size_t)u.pn * 256 * ldb + (size_t)u.kk * b_kk); }
};
struct Sched {
    int nM, nN, G, c, kdiv, nmain, extra_n, extra_pm0, extra_pn0, extra_npn;
    __device__ __forceinline__ void init(int nM_, int nN_, int G_, int c_, int kdiv_ = 1, int extra_n_ = 0, int epm0 = 0, int epn0 = 0, int enpn = 1) {
        nM = nM_; nN = nN_; G = G_; c = c_; kdiv = kdiv_; nmain = nM * nN; extra_n = extra_n_; extra_pm0 = epm0; extra_pn0 = epn0; extra_npn = enpn; }
    __device__ __forceinline__ bool next(int i, Unit& u) const {
        const int ti = (kdiv == 2) ? (i >> 1) : i; u.kk = (kdiv == 2) ? (i & 1) : 0;
        const long L = (long)ti * G + c;
        if (L < nmain) {
            int wgid = (int)L; { const int q = nmain / NXCD, r = nmain % NXCD, xcd = wgid % NXCD, off = wgid / NXCD; wgid = (xcd < r ? xcd * (q + 1) : r * (q + 1) + (xcd - r) * q) + off; }
            const int nig = WGM * nN, gid = wgid / nig, fm = gid * WGM, gsz = (nM - fm) < WGM ? (nM - fm) : WGM;
            u.pm = fm + ((wgid % nig) % gsz); u.pn = (wgid % nig) / gsz; return true;
        }
        const int e = (int)(L - nmain); if (e >= extra_n) return false;
        u.pm = extra_pm0 + e / extra_npn; u.pn = extra_pn0 + e % extra_npn; return true;
    }
};

template <class Epi>
__device__ __forceinline__ void gemm_phase(LAS unsigned char* lds, const Gemm g, const Sched& S, const Epi& E, int wave_) {
    const int tid_ = fresh_lane() + wave_ * 64;
    const int tid = tid_, wid = __builtin_amdgcn_readfirstlane(tid >> 6), lane = tid & 63, wr = wid >> 2, wc = wid & 3, fr = lane & 15, fq = lane >> 4;
    int K_ = g.K; asm volatile("" : "+s"(K_));
    const int K = K_, nt = K / BK;
    unsigned voffA, voffB;
    { int R, C; stage_rc(tid * 16, R, C); voffA = (unsigned)(R * g.lda + C) * 2u; voffB = (unsigned)(R * g.ldb + C) * 2u; }
    const size_t qvoffA = (size_t)64 * g.lda * 2, qvoffB = (size_t)64 * g.ldb * 2;
    const size_t kstep = (size_t)(BK * 2);
    const size_t hstepA = (size_t)HALF * g.lda * 2, hstepB = (size_t)HALF * g.ldb * 2;
    const unsigned ldsw = (unsigned)wid * 1024u;
    const int aoff = lds_byte(wr * 64 + fr, fq * 8), boff = lds_byte(wc * 32 + fr, fq * 8);
#define PG8_SA(b, h) (((b) * 2 + (h)) * HTB)
#define PG8_SB(b, h) ((4 + (b) * 2 + (h)) * HTB)
#define PG8_STAGE(bufoff, gbase, voff) do { _Pragma("unroll") for (int _i = 0; _i < 2; ++_i) \
        __builtin_amdgcn_global_load_lds((const unsigned*)((const char*)(gbase) + (size_t)_i * q##voff + (voff)), (LAS unsigned*)(lds + (bufoff) + ldsw + _i * 8192), 16, 0, 0); } while (0)
#define PG8_LDA(dst, b, h) do { _Pragma("unroll") for (int m = 0; m < 4; ++m) _Pragma("unroll") for (int k = 0; k < 2; ++k) dst[m][k] = *(const LAS bf16x8*)(lds + PG8_SA(b, h) + aoff + m * 2048 + k * 1024); } while (0)
#define PG8_LDB(dst, b, h) do { _Pragma("unroll") for (int n = 0; n < 2; ++n) _Pragma("unroll") for (int k = 0; k < 2; ++k) dst[n][k] = *(const LAS bf16x8*)(lds + PG8_SB(b, h) + boff + n * 2048 + k * 1024); } while (0)
#define PG8_MMA(ai, bj, At, Bt) do { __builtin_amdgcn_s_setprio(1); _Pragma("unroll") for (int m = 0; m < 4; ++m) _Pragma("unroll") for (int n = 0; n < 2; ++n) _Pragma("unroll") for (int k = 0; k < 2; ++k) \
        acc[ai][bj][m][n] = __builtin_amdgcn_mfma_f32_16x16x32_bf16(Bt[n][k], At[m][k], acc[ai][bj][m][n], 0, 0, 0); __builtin_amdgcn_s_setprio(0); } while (0)
#define PG8_WAIT_V(n) asm volatile("s_waitcnt vmcnt(" #n ")" ::: "memory")
#define PG8_WAIT_L(n) asm volatile("s_waitcnt lgkmcnt(" #n ")" ::: "memory")
#define PG8_BAR __builtin_amdgcn_s_barrier()
#define PG8_SCHED __builtin_amdgcn_sched_barrier(0)
    Unit cur, nxt; int ui = 0;
    if (!S.next(0, cur)) return;
    f32x4 acc[2][2][4][2];
#pragma unroll
    for (int a = 0; a < 2; ++a)
#pragma unroll
        for (int b = 0; b < 2; ++b)
#pragma unroll
            for (int m = 0; m < 4; ++m)
#pragma unroll
                for (int n = 0; n < 2; ++n) acc[a][b][m][n] = (f32x4){0.f, 0.f, 0.f, 0.f};
    bf16x8 At[4][2], B0[2][2], B1[2][2];
    const char* cA = g.a_ptr(cur); const char* cB = g.b_ptr(cur);
    PG8_STAGE(PG8_SB(0, 0), cB, voffB); PG8_STAGE(PG8_SB(0, 1), cB + hstepB, voffB); PG8_STAGE(PG8_SA(0, 0), cA, voffA); PG8_STAGE(PG8_SA(0, 1), cA + hstepA, voffA);
    if (wr == 1) PG8_BAR;
    PG8_WAIT_V(2); PG8_BAR;
    PG8_STAGE(PG8_SB(1, 0), cB + kstep, voffB); PG8_STAGE(PG8_SA(1, 0), cA + kstep, voffA); PG8_STAGE(PG8_SB(1, 1), cB + hstepB + kstep, voffB);
    PG8_WAIT_V(6); PG8_BAR;
    for (;;) {
        const bool has_next = S.next(ui + 1, nxt);
        const char* nA = has_next ? g.a_ptr(nxt) : cA; const char* nB = has_next ? g.b_ptr(nxt) : cB;
        for (int t = 0; t < nt; t += 2) {
            const bool last = (t == nt - 2);
            const char* a1 = cA + (size_t)(t + 1) * kstep;
            const char* a2 = last ? nA : cA + (size_t)(t + 2) * kstep; const char* b2 = last ? nB : cB + (size_t)(t + 2) * kstep;
            const char* a3 = a2 + kstep; const char* b3 = b2 + kstep;
            PG8_LDB(B0, 0, 0); PG8_LDB(B1, 0, 1); PG8_SCHED; PG8_LDA(At, 0, 0); PG8_STAGE(PG8_SA(1, 1), a1 + hstepA, voffA);
            PG8_WAIT_V(8); PG8_WAIT_L(0); PG8_BAR; PG8_MMA(0, 0, At, B0); PG8_MMA(0, 1, At, B1); PG8_BAR; PG8_SCHED;
            PG8_LDA(At, 0, 1); PG8_STAGE(PG8_SB(0, 0), b2, voffB); PG8_STAGE(PG8_SB(0, 1), b2 + hstepB, voffB); PG8_STAGE(PG8_SA(0, 0), a2, voffA);
            PG8_WAIT_V(8); PG8_WAIT_L(0); PG8_BAR; PG8_MMA(1, 0, At, B0); PG8_MMA(1, 1, At, B1); PG8_BAR; PG8_SCHED;
            PG8_LDB(B0, 1, 0); PG8_LDB(B1, 1, 1); PG8_SCHED; PG8_LDA(At, 1, 0); PG8_STAGE(PG8_SA(0, 1), a2 + hstepA, voffA);
            PG8_WAIT_V(8); PG8_WAIT_L(0); PG8_BAR; PG8_MMA(0, 0, At, B0); PG8_MMA(0, 1, At, B1); PG8_BAR; PG8_SCHED;
            PG8_LDA(At, 1, 1); PG8_STAGE(PG8_SB(1, 0), b3, voffB); PG8_STAGE(PG8_SB(1, 1), b3 + hstepB, voffB); PG8_STAGE(PG8_SA(1, 0), a3, voffA);
            PG8_WAIT_V(8); PG8_WAIT_L(0); PG8_BAR; PG8_MMA(1, 0, At, B0); PG8_MMA(1, 1, At, B1); PG8_BAR; PG8_SCHED;
        }
        if (wr == 0) PG8_BAR;
        const int eln = fresh_lane();
        const int efr = eln & 15, efq = eln >> 4; int ewr = wr, ewc = wc; asm volatile("" : "+s"(ewr), "+s"(ewc));
        const bool keep = E(acc, cur, ewr, ewc, efr, efq);
        if (!has_next) break;
        if (!keep) {
#pragma unroll
            for (int a = 0; a < 2; ++a)
#pragma unroll
                for (int b = 0; b < 2; ++b)
#pragma unroll
                    for (int m = 0; m < 4; ++m)
#pragma unroll
                        for (int n = 0; n < 2; ++n) acc[a][b][m][n] = (f32x4){0.f, 0.f, 0.f, 0.f};
        }
        cur = nxt; cA = nA; cB = nB; ++ui;
        if (wr == 1) PG8_BAR;
    }
    PG8_WAIT_V(0);
    PG8_BAR;
#undef PG8_SA
#undef PG8_SB
#undef PG8_STAGE
#undef PG8_LDA
#undef PG8_LDB
#undef PG8_MMA
#undef PG8_WAIT_V
#undef PG8_WAIT_L
#undef PG8_BAR
#undef PG8_SCHED
}
}
using pg8::Unit;
typedef f32x4 Acc[2][2][4][2];

struct EpiG1 {
    bf16_t* BIG; bf16_t* XC; bf16_t* SZB; bf16_t* RAT; bf16_t* SMB;
    const float* w3; const float* w4; const float* b4;
    LAS float* scr;
    __device__ __forceinline__ bool operator()(Acc& acc, const Unit& u, int wr, int wc, int fr, int fq) const {
        const int pm = u.pm, pn = u.pn;
        const bool isctx = pm >= 64;
        const unsigned row0 = (unsigned)pm * 256 + wr * 64 + fr;
        const f32x4 zero4 = (f32x4){0.f, 0.f, 0.f, 0.f};
        if (pn < 16) {
            const int ch0 = 64 * pn + 16 * wc + 4 * fq;
            const f32x4 w0 = *(const f32x4*)(w3 + ch0), w1 = *(const f32x4*)(w3 + 1024 + ch0), w2 = *(const f32x4*)(w3 + 2048 + ch0);
#pragma unroll
            for (int ai = 0; ai < 2; ++ai)
#pragma unroll
                for (int m = 0; m < 4; ++m) acc[ai][0][m][0] = acc[ai][0][m][0] * acc[ai][0][m][1];
            const int col = 16 * wc + 4 * fq;
            if (isctx) {
#pragma unroll
                for (int ai = 0; ai < 2; ++ai) { const int seg = 2 * ai + wr;
                    if (fr == 0) *(LAS f32x4*)(scr + (seg * 2 + 0) * 64 + col) = acc[ai][0][0][0];
                    if (fr == 15) *(LAS f32x4*)(scr + (seg * 2 + 1) * 64 + col) = acc[ai][0][3][0]; }
                WG_BAR();
            }
#pragma unroll
            for (int ai = 0; ai < 2; ++ai) {
                const int seg = 2 * ai + wr;
                f32x4 hp = zero4, hn = zero4;
                if (isctx) { if (seg > 0) hp = *(const LAS f32x4*)(scr + ((seg - 1) * 2 + 1) * 64 + col); if (seg < 3) hn = *(const LAS f32x4*)(scr + ((seg + 1) * 2 + 0) * 64 + col); }
#pragma unroll
                for (int m = 0; m < 4; ++m) {
                    const f32x4 po = m > 0 ? dpp4<DPP_ROR(1)>(zero4, acc[ai][0][m > 0 ? m - 1 : 0][0]) : hp;
                    const f32x4 no = m < 3 ? dpp4<DPP_ROR(15)>(zero4, acc[ai][0][m < 3 ? m + 1 : 3][0]) : hn;
                    const f32x4 prev = dpp4<DPP_SHR(1)>(po, acc[ai][0][m][0]);
                    const f32x4 next = dpp4<DPP_SHL(1)>(no, acc[ai][0][m][0]);
                    const f32x4 cv = w0 * prev + w1 * acc[ai][0][m][0] + w2 * next;
                    const f32x4 y = acc[ai][1][m][0] * cv * silu4(acc[ai][1][m][1]);
                    *(u32x2*)(BIG + (size_t)(row0 + ai * 128 + m * 16) * 2048 + ch0) = pack4(y);
                }
            }
            if (isctx) WG_BAR();
        } else if (pn < 20) {
            if (isctx) {
#pragma unroll
                for (int ai = 0; ai < 2; ++ai) { const int seg = 2 * ai + wr;
#pragma unroll
                    for (int bj = 0; bj < 2; ++bj)
#pragma unroll
                        for (int n = 0; n < 2; ++n) { const int col = 128 * bj + 32 * wc + 16 * n + 4 * fq;
                            if (fr == 0) *(LAS f32x4*)(scr + (seg * 3 + 0) * 256 + col) = acc[ai][bj][0][n];
                            if (fr == 14) *(LAS f32x4*)(scr + (seg * 3 + 1) * 256 + col) = acc[ai][bj][3][n];
                            if (fr == 15) *(LAS f32x4*)(scr + (seg * 3 + 2) * 256 + col) = acc[ai][bj][3][n]; } }
                WG_BAR();
            }
#pragma unroll
            for (int bj = 0; bj < 2; ++bj) {
                const int ch0 = 256 * (pn - 16) + 128 * bj + 32 * wc + 8 * fq;
#pragma unroll
                for (int ai = 0; ai < 2; ++ai) {
                    const int seg = 2 * ai + wr;
                    u32x2 pk[4];
#pragma unroll
                    for (int n = 0; n < 2; ++n) {
                        const int ch = ch0 + 4 * n, col = 128 * bj + 32 * wc + 16 * n + 4 * fq;
                        const f32x4 k0 = *(const f32x4*)(w4 + ch), k1 = *(const f32x4*)(w4 + 1024 + ch), k2 = *(const f32x4*)(w4 + 2048 + ch), k3 = *(const f32x4*)(w4 + 3072 + ch), kb = *(const f32x4*)(b4 + ch);
                        f32x4 hp1 = zero4, hp2 = zero4, hn1 = zero4;
                        if (isctx) {
                            if (seg > 0) { hp2 = *(const LAS f32x4*)(scr + ((seg - 1) * 3 + 1) * 256 + col); hp1 = *(const LAS f32x4*)(scr + ((seg - 1) * 3 + 2) * 256 + col); }
                            if (seg < 3) hn1 = *(const LAS f32x4*)(scr + ((seg + 1) * 3 + 0) * 256 + col); }
#pragma unroll
                        for (int m = 0; m < 4; ++m) {
                            const f32x4 x = acc[ai][bj][m][n];
                            const f32x4 o1 = m > 0 ? dpp4<DPP_ROR(1)>(zero4, acc[ai][bj][m > 0 ? m - 1 : 0][n]) : hp1;
                            const f32x4 o2 = m > 0 ? dpp4<DPP_ROR(2)>(zero4, acc[ai][bj][m > 0 ? m - 1 : 0][n]) : sel4(fr == 0, hp2, hp1);
                            const f32x4 on = m < 3 ? dpp4<DPP_ROR(15)>(zero4, acc[ai][bj][m < 3 ? m + 1 : 3][n]) : hn1;
                            const f32x4 p1 = dpp4<DPP_SHR(1)>(o1, x), p2 = dpp4<DPP_SHR(2)>(o2, x), n1 = dpp4<DPP_SHL(1)>(on, x);
                            const f32x4 o = k0 * p2 + k1 * p1 + k2 * x + k3 * n1 + kb;
                            if (n == 0) pk[m] = pack4(o);
                            else { const u32x2 b = pack4(o); *(u32x4*)(XC + (size_t)(row0 + ai * 128 + m * 16) * 1024 + ch0) = (u32x4){pk[m].x, pk[m].y, b.x, b.y}; }
                        }
                    }
                }
            }
            if (isctx) WG_BAR();
        } else if (pn < 24) {
#pragma unroll
            for (int bj = 0; bj < 2; ++bj) { const int ch0 = 256 * (pn - 20) + 128 * bj + 32 * wc + 8 * fq;
#pragma unroll
                for (int ai = 0; ai < 2; ++ai)
#pragma unroll
                    for (int m = 0; m < 4; ++m) { const u32x2 a = pack4(silu4(acc[ai][bj][m][0])), b = pack4(silu4(acc[ai][bj][m][1]));
                        *(u32x4*)(SZB + (size_t)(row0 + ai * 128 + m * 16) * 1024 + ch0) = (u32x4){a.x, a.y, b.x, b.y}; } }
        } else {
            const int ch0 = 128 * (pn - 24) + 32 * wc + 8 * fq;
#pragma unroll
            for (int ai = 0; ai < 2; ++ai)
#pragma unroll
                for (int m = 0; m < 4; ++m) {
                    const f32x4 sa0 = sigmoid4(acc[ai][0][m][0]), sa1 = sigmoid4(acc[ai][0][m][1]), sb0 = sigmoid4(acc[ai][1][m][0]), sb1 = sigmoid4(acc[ai][1][m][1]);
                    f32x4 q0, q1;
#pragma unroll
                    for (int j = 0; j < 4; ++j) { q0[j] = sa0[j] * __builtin_amdgcn_rcpf(sb0[j]); q1[j] = sa1[j] * __builtin_amdgcn_rcpf(sb1[j]); }
                    const size_t off = (size_t)(row0 + ai * 128 + m * 16) * 1024 + ch0;
                    { const u32x2 a = pack4(q0), b = pack4(q1); *(u32x4*)(RAT + off) = (u32x4){a.x, a.y, b.x, b.y}; }
                    { const u32x2 a = pack4(sb0), b = pack4(sb1); *(u32x4*)(SMB + off) = (u32x4){a.x, a.y, b.x, b.y}; }
                }
        }
        return false;
    }
};

template <int MODE> struct EpiS {
    const bf16_t* XC; const bf16_t* SZB; bf16_t* BIG;
    const float* br; const float* bi; const float* clam;
    float* AGG; const float* CARRY;
    LAS float* scr;
    __device__ __forceinline__ bool operator()(Acc& acc, const Unit& u, int wr, int wc, int fr, int fq) const {
        const int pm = u.pm, pn = u.pn;
        const int cl = 16 * wc + 4 * fq, ch0 = 64 * pn + cl;
        const unsigned row0 = (unsigned)pm * 256 + wr * 64 + fr;
        const f32x4 one4 = (f32x4){1.f, 1.f, 1.f, 1.f}, zero4 = (f32x4){0.f, 0.f, 0.f, 0.f};
#pragma unroll
        for (int d = 0; d < 2; ++d) {
            const f32x4 brv = *(const f32x4*)(br + d * 1024 + ch0), biv = *(const f32x4*)(bi + d * 1024 + ch0);
            const f32x4 cv = *(const f32x4*)(clam + d * 1024 + ch0) * LOG2E;
#pragma unroll
            for (int ai = 0; ai < 2; ++ai)
#pragma unroll
                for (int m = 0; m < 4; ++m) {
                    const u32x2 xw = *(const u32x2*)(XC + (size_t)(row0 + ai * 128 + m * 16) * 1024 + ch0);
#pragma unroll
                    for (int jp = 0; jp < 2; ++jp) {
                        const unsigned w = jp ? xw.y : xw.x;
#pragma unroll
                        for (int jj = 0; jj < 2; ++jj) { const int j = 2 * jp + jj;
                            const float x = jj ? bf_hi(w) : bf_lo(w);
                            const float r = sigmoidf_(acc[ai][d][m][0][j] + brv[j]), ig = sigmoidf_(acc[ai][d][m][1][j] + biv[j]);
                            const float la2 = cv[j] * r;
                            const float a = __builtin_amdgcn_exp2f(la2);
                            const float xx = la2 * (2.0f / LOG2E);
                            const float om = xx > -0.02f ? -xx * (1.0f + xx * (0.5f + xx * 0.16666667f)) : 1.0f - a * a;
                            acc[ai][d][m][0][j] = a; acc[ai][d][m][1][j] = __builtin_amdgcn_sqrtf(om) * ig * x; }
                        __builtin_amdgcn_sched_barrier(0);
                    }
                    asm volatile("" ::: "memory");
                }
        }
#pragma unroll
        for (int ai = 0; ai < 2; ++ai) {
#pragma unroll
            for (int m = 0; m < 4; ++m) {
                f32x4 a = acc[ai][0][m][0], l = acc[ai][0][m][1];
                { const f32x4 as = dpp4<DPP_SHR(1)>(one4, a), ls = dpp4<DPP_SHR(1)>(zero4, l); l = a * ls + l; a = a * as; }
                { const f32x4 as = dpp4<DPP_SHR(2)>(one4, a), ls = dpp4<DPP_SHR(2)>(zero4, l); l = a * ls + l; a = a * as; }
                { const f32x4 as = dpp4<DPP_SHR(4)>(one4, a), ls = dpp4<DPP_SHR(4)>(zero4, l); l = a * ls + l; a = a * as; }
                { const f32x4 as = dpp4<DPP_SHR(8)>(one4, a), ls = dpp4<DPP_SHR(8)>(zero4, l); l = a * ls + l; a = a * as; }
                if (m > 0) { const f32x4 pc = dpp4<DPP_BCAST(15)>(zero4, acc[ai][0][m > 0 ? m - 1 : 0][0]), lc = dpp4<DPP_BCAST(15)>(zero4, acc[ai][0][m > 0 ? m - 1 : 0][1]); l = a * lc + l; a = a * pc; }
                acc[ai][0][m][0] = a; acc[ai][0][m][1] = l;
                __builtin_amdgcn_sched_barrier(0);
            }
#pragma unroll
            for (int mm = 0; mm < 4; ++mm) { const int m = 3 - mm;
                f32x4 a = acc[ai][1][m][0], l = acc[ai][1][m][1];
                { const f32x4 as = dpp4<DPP_SHL(1)>(one4, a), ls = dpp4<DPP_SHL(1)>(zero4, l); l = a * ls + l; a = a * as; }
                { const f32x4 as = dpp4<DPP_SHL(2)>(one4, a), ls = dpp4<DPP_SHL(2)>(zero4, l); l = a * ls + l; a = a * as; }
                { const f32x4 as = dpp4<DPP_SHL(4)>(one4, a), ls = dpp4<DPP_SHL(4)>(zero4, l); l = a * ls + l; a = a * as; }
                { const f32x4 as = dpp4<DPP_SHL(8)>(one4, a), ls = dpp4<DPP_SHL(8)>(zero4, l); l = a * ls + l; a = a * as; }
                if (m < 3) { const f32x4 pc = dpp4<DPP_BCAST(0)>(zero4, acc[ai][1][m < 3 ? m + 1 : 3][0]), lc = dpp4<DPP_BCAST(0)>(zero4, acc[ai][1][m < 3 ? m + 1 : 3][1]); l = a * lc + l; a = a * pc; }
                acc[ai][1][m][0] = a; acc[ai][1][m][1] = l;
                __builtin_amdgcn_sched_barrier(0);
            }
            const int seg = 2 * ai + wr;
            if (fr == 15) {
#pragma unroll
                for (int j = 0; j < 4; ++j) *(LAS f32x2*)(scr + ((seg * 2 + 0) * 64 + cl + j) * 2) = (f32x2){acc[ai][0][3][0][j], acc[ai][0][3][1][j]};
            }
            if (fr == 0) {
#pragma unroll
                for (int j = 0; j < 4; ++j) *(LAS f32x2*)(scr + ((seg * 2 + 1) * 64 + cl + j) * 2) = (f32x2){acc[ai][1][0][0][j], acc[ai][1][0][1][j]};
            }
        }
        WG_BAR();
        {
            const int t = (wr * 4 + wc) * 64 + fq * 16 + fr;
            LAS float* car = scr + 1024;
            if (t < 128) { const int d = t >> 6, c = t & 63;
                if constexpr (MODE == 0) { float A = 1.f, Bv = 0.f;
#pragma unroll
                    for (int s = 0; s < 4; ++s) { const int seg = d ? 3 - s : s; const f32x2 tb = *(const LAS f32x2*)(scr + ((seg * 2 + d) * 64 + c) * 2); Bv = tb.x * Bv + tb.y; A = A * tb.x; }
                    *(f32x2*)(AGG + ((size_t)(pm * 2 + d) * 1024 + 64 * pn + c) * 2) = (f32x2){A, Bv};
                } else { float h = CARRY[(size_t)(pm * 2 + d) * 1024 + 64 * pn + c];
#pragma unroll
                    for (int s = 0; s < 4; ++s) { const int seg = d ? 3 - s : s; car[(seg * 2 + d) * 64 + c] = h; const f32x2 tb = *(const LAS f32x2*)(scr + ((seg * 2 + d) * 64 + c) * 2); h = tb.x * h + tb.y; }
                }
            }
            if constexpr (MODE == 1) {
                WG_BAR();
#pragma unroll
                for (int ai = 0; ai < 2; ++ai) {
                    const int seg = 2 * ai + wr;
                    const f32x4 hf = *(const LAS f32x4*)(car + (seg * 2 + 0) * 64 + cl), hb = *(const LAS f32x4*)(car + (seg * 2 + 1) * 64 + cl);
#pragma unroll
                    for (int m = 0; m < 4; ++m) {
                        const size_t r = row0 + ai * 128 + m * 16;
                        const f32x4 z = unpack4(*(const u32x2*)(SZB + r * 1024 + ch0));
                        const f32x4 y = (acc[ai][0][m][0] * hf + acc[ai][0][m][1]) + (acc[ai][1][m][0] * hb + acc[ai][1][m][1]);
                        *(u32x2*)(BIG + r * 2048 + 1024 + ch0) = pack4(y * z);
                        if (m & 1) asm volatile("" ::: "memory");
                    }
                }
            }
        }
        WG_BAR();
        return false;
    }
};

struct EpiG2 {
    const bf16_t* RAT; const bf16_t* SMB; bf16_t* MG;
    __device__ __forceinline__ bool operator()(Acc& acc, const Unit& u, int wr, int wc, int fr, int fq) const {
        const size_t row0 = (size_t)u.pm * 256 + wr * 64 + fr; const int col0 = 256 * u.pn + 32 * wc + 8 * fq;
        const bf16_t* src = u.kk == 0 ? RAT : SMB;
#pragma unroll
        for (int ai = 0; ai < 2; ++ai)
#pragma unroll
            for (int m = 0; m < 4; ++m)
#pragma unroll
                for (int bj = 0; bj < 2; ++bj) {
                    const size_t off = (row0 + ai * 128 + m * 16) * 1024 + col0 + 128 * bj;
                    const u32x4 w = *(const u32x4*)(src + off);
                    acc[ai][bj][m][0] = acc[ai][bj][m][0] * unpack4((u32x2){w.x, w.y});
                    acc[ai][bj][m][1] = acc[ai][bj][m][1] * unpack4((u32x2){w.z, w.w});
                    if (u.kk == 1) { const u32x2 a = pack4(acc[ai][bj][m][0]), b = pack4(acc[ai][bj][m][1]); *(u32x4*)(MG + off) = (u32x4){a.x, a.y, b.x, b.y}; }
                }
        return u.kk == 0;
    }
};

struct EpiG3 {
    const float* xin_lat; const float* xin_ctx; float* out_lat; float* out_ctx; const float* mod;
    __device__ __forceinline__ bool operator()(Acc& acc, const Unit& u, int wr, int wc, int fr, int fq) const {
        const int pm = u.pm; const bool isctx = pm >= 64; const int v = isctx ? 2 : (pm >> 5);
        const float* xin = isctx ? xin_ctx : xin_lat; float* out = isctx ? out_ctx : out_lat;
        const size_t row0 = (size_t)(isctx ? pm - 64 : pm) * 256 + wr * 64 + fr; const int col0 = 256 * u.pn + 32 * wc + 4 * fq;
        f32x4 gt[2][2];
#pragma unroll
        for (int bj = 0; bj < 2; ++bj)
#pragma unroll
            for (int n = 0; n < 2; ++n) gt[bj][n] = *(const f32x4*)(mod + v * 3072 + 2048 + col0 + 128 * bj + 16 * n);
#pragma unroll
        for (int ai = 0; ai < 2; ++ai)
#pragma unroll
            for (int m = 0; m < 4; ++m)
#pragma unroll
                for (int bj = 0; bj < 2; ++bj)
#pragma unroll
                    for (int n = 0; n < 2; ++n) { const size_t off = (row0 + ai * 128 + m * 16) * 1024 + col0 + 128 * bj + 16 * n;
                        *(f32x4*)(out + off) = *(const f32x4*)(xin + off) + gt[bj][n] * acc[ai][bj][m][n]; }
        return false;
    }
};

#define XB_TMO      128
#define XB_XCNT(j)  (256  + 64 * (j))
#define XB_XSUB(j)  (1280 + 64 * (j))
#define XB_XGEN(j)  (2304 + 64 * (j))
#define XB_TOP      3328
#define XB_TOPGEN   3392
#define XCD_BAR_WORDS 3456
#define XB_SPIN_CAP (1u << 18)
__device__ __forceinline__ unsigned xb_ld(unsigned* p)              { return __hip_atomic_load(p, __ATOMIC_RELAXED, __HIP_MEMORY_SCOPE_AGENT); }
__device__ __forceinline__ unsigned xb_add(unsigned* p, unsigned v) { return __hip_atomic_fetch_add(p, v, __ATOMIC_RELAXED, __HIP_MEMORY_SCOPE_AGENT); }
__device__ __forceinline__ unsigned xb_xcc_id() { return (unsigned)__builtin_amdgcn_s_getreg((3 << 11) | 20) & 0xFu; }
#define XB_SPIN(cond, bar) do { unsigned _sp = 0; while (cond) { __builtin_amdgcn_s_sleep(1); \
    if ((++_sp & 255u) == 0u) { if (xb_ld(&(bar)[XB_TMO])) break; if (_sp > XB_SPIN_CAP) { atomicAdd(&(bar)[XB_TMO], 1u); break; } } } } while (0)
struct XcdBarrier { unsigned* bar; unsigned x; volatile LAS unsigned* st; };
__device__ __forceinline__ XcdBarrier xcd_barrier_post(unsigned* bar, volatile LAS unsigned* st) {
    XcdBarrier b; b.bar = bar; b.x = xb_xcc_id(); b.st = st;
    if (threadIdx.x == 0) (void)xb_add(&bar[XB_XCNT(b.x)], 1u);
    return b;
}
__device__ __forceinline__ void xcd_barrier_complete(unsigned* bar, unsigned x, unsigned& nloc, unsigned& nx) {
    const unsigned G = gridDim.x * gridDim.y * gridDim.z;
    unsigned sum, cnt, mine, sp = 0u;
    for (;;) {
        sum = 0u; cnt = 0u; mine = 0u;
#pragma unroll
        for (unsigned j = 0; j < 16; ++j) { const unsigned c = xb_ld(&bar[XB_XCNT(j)]); sum += c; cnt += (c > 0u) ? 1u : 0u; mine = (j == x) ? c : mine; }
        if (sum == G) break;
        __builtin_amdgcn_s_sleep(1);
        if ((++sp & 255u) == 0u) { if (xb_ld(&bar[XB_TMO])) break; if (sp > XB_SPIN_CAP) { atomicAdd(&bar[XB_TMO], 1u); break; } }
    }
    nloc = mine > 0u ? mine : 1u; nx = cnt > 0u ? cnt : 1u;
}
__device__ __forceinline__ void xcd_barrier(const XcdBarrier& b, bool leader) {
    asm volatile("s_waitcnt vmcnt(0)" ::: "memory");
    __syncthreads();
    if (leader) {
        unsigned* bar = b.bar;
        __builtin_amdgcn_s_waitcnt(0);
        unsigned nloc = b.st[0], nx = b.st[1];
        if (nloc == 0u) { xcd_barrier_complete(bar, b.x, nloc, nx); b.st[0] = nloc; b.st[1] = nx; }
        const unsigned old = xb_add(&bar[XB_XSUB(b.x)], 1u);
        const unsigned gen = old / nloc;
        if (old + 1u == (gen + 1u) * nloc) {
            __builtin_amdgcn_fence(__ATOMIC_RELEASE, "agent");
            asm volatile("s_waitcnt vmcnt(0)" ::: "memory");
            const unsigned og = xb_add(&bar[XB_TOP], 1u);
            const unsigned tg = og / nx;
            if (og + 1u == (tg + 1u) * nx) xb_add(&bar[XB_TOPGEN], 1u);
            else XB_SPIN(xb_ld(&bar[XB_TOPGEN]) == tg, bar);
            __builtin_amdgcn_fence(__ATOMIC_ACQUIRE, "agent");
            xb_add(&bar[XB_XGEN(b.x)], 1u);
            asm volatile("s_waitcnt vmcnt(0)" ::: "memory");
        } else {
            XB_SPIN(xb_ld(&bar[XB_XGEN(b.x)]) == gen, bar);
            __builtin_amdgcn_fence(__ATOMIC_ACQUIRE, "agent");
            asm volatile("s_waitcnt vmcnt(0)" ::: "memory");
        }
    }
    __syncthreads();
}

struct Args { const float* in[20]; float* out; unsigned char* ws; int ph_lo, ph_hi; };
typedef __attribute__((address_space(4))) const Args CArgs;
struct InTab { CArgs* ka; __device__ __forceinline__ const float* operator[](int i) const { return ka->in[i]; } };
struct Frame {
    LAS unsigned char* lds; int tid, lane, wave, vcu, G;
    InTab in; float* out; unsigned char* ws;
    __device__ __forceinline__ void ids() { const int l = fresh_lane(); lane = l; tid = wave * 64 + l; }
};
__device__ __forceinline__ int opaque_v(int x) { asm volatile("" : "+v"(x)); return x; }
__device__ __forceinline__ float wave_sum(float v, int lane) {
#pragma unroll
    for (int o = 1; o < 64; o <<= 1) v += __builtin_bit_cast(float, __builtin_amdgcn_ds_bpermute((lane ^ o) << 2, __builtin_bit_cast(int, v)));
    return v;
}

__device__ __forceinline__ int w1_dest_row(int s) {
    const int chunk = s >> 10, ch = s & 1023;
    if (chunk < 4) { const int g = chunk == 0 ? 0 : (chunk == 1 ? 2 : (chunk == 2 ? 1 : 3)); return 256 * (ch >> 6) + 128 * (g >> 1) + 32 * ((ch >> 4) & 3) + 16 * (g & 1) + (ch & 15); }
    if (chunk < 6) { const int pn = (chunk == 4 ? 16 : 20) + (ch >> 8), r = ch & 255; return 256 * pn + 128 * (r >> 7) + 32 * ((r >> 5) & 3) + 16 * ((r >> 2) & 1) + 4 * ((r >> 3) & 3) + (r & 3); }
    { const int pn = 24 + (ch >> 7), r = ch & 127; return 256 * pn + 128 * (chunk - 6) + 32 * (r >> 5) + 16 * ((r >> 2) & 1) + 4 * ((r >> 3) & 3) + (r & 3); }
}
__device__ __forceinline__ int perm8_dest_row(int o) { return (o & ~31) | (((o >> 2) & 1) << 4) | (((o >> 3) & 3) << 2) | (o & 3); }
template <int MODE> __device__ __forceinline__ void tr_item(const float* W, int ldsrc, int k0, int n0, bf16_t* dst, int lddst, int dcol0, int p0, LAS float* scr, int lane) {
#pragma unroll 8
    for (int i = 0; i < 32; ++i) { const int kk = 2 * i + (lane >> 5); scr[kk * 33 + (lane & 31)] = W[(size_t)(k0 + kk) * ldsrc + n0 + (lane & 31)]; }
    LDS_WAIT(); asm volatile("" ::: "memory");
    const int c = lane & 7;
#pragma unroll
    for (int j = 0; j < 4; ++j) { const int n = (lane >> 3) + 8 * j; const LAS float* s = scr + (8 * c) * 33 + n;
        u32x4 o; o.x = cvt_pk_bf16(s[0 * 33], s[1 * 33]); o.y = cvt_pk_bf16(s[2 * 33], s[3 * 33]); o.z = cvt_pk_bf16(s[4 * 33], s[5 * 33]); o.w = cvt_pk_bf16(s[6 * 33], s[7 * 33]);
        const int sn = n0 + n; int drow;
        if (MODE == 0) drow = w1_dest_row(sn);
        else if (MODE == 1) drow = perm8_dest_row(sn);
        else if (MODE == 2) drow = sn;
        else drow = p0 + 256 * (sn >> 6) + 32 * ((sn >> 4) & 3) + (sn & 15);
        *(u32x4*)(dst + (size_t)drow * lddst + dcol0 + k0 + 8 * c) = o; }
    LDS_WAIT(); asm volatile("" ::: "memory");
}
__device__ __forceinline__ void p0_prologue(Frame& F) {
    F.ids();
    const float* c = F.in[1]; const float* c_ctx = F.in[3]; const float* w_ada = F.in[4]; const float* b_ada = F.in[5];
    float* MOD = (float*)(F.ws + WS_MOD);
    if ((int)blockIdx.x < 96) {
        LAS float* sc = (LAS float*)F.lds;
        LAS float* red = sc + 3072;
        for (int i = F.tid; i < 3072; i += 512) { const float x = i < 2048 ? c[i] : c_ctx[i - 2048]; sc[i] = x * sigmoidf_(x); }
        __syncthreads();
        for (int u = blockIdx.x; u < 96; u += F.G) {
            const int l = u / 48, col = (u % 48) * 64 + F.lane, k0 = F.wave * 128;
            const float* W = w_ada + (size_t)l * 1024 * 3072 + col;
            float a0 = 0.f, a1 = 0.f, a2 = 0.f;
#pragma unroll 8
            for (int k = k0; k < k0 + 128; ++k) { const float w = W[(size_t)k * 3072]; a0 += sc[k] * w; a1 += sc[1024 + k] * w; a2 += sc[2048 + k] * w; }
            red[(F.wave * 3 + 0) * 64 + F.lane] = a0; red[(F.wave * 3 + 1) * 64 + F.lane] = a1; red[(F.wave * 3 + 2) * 64 + F.lane] = a2;
            __syncthreads();
            if (F.wave < 3) { float s = 0.f;
#pragma unroll
                for (int w = 0; w < 8; ++w) s += red[(w * 3 + F.wave) * 64 + F.lane];
                MOD[(l * 3 + F.wave) * 3072 + col] = s + b_ada[l * 3072 + col]; }
            __syncthreads();
        }
    }
    __syncthreads();
    { const int gi = blockIdx.x * 512 + F.tid; if (gi < NL * 2 * 1024) { const float e = __builtin_amdgcn_exp2f(-F.in[15][gi] * LOG2E);
            ((float*)(F.ws + WS_CLAM))[gi] = -8.0f * (e * (1.0f + e * (-0.5f + e * (0.33333334f + e * (-0.25f + e * 0.2f))))); } }
    LAS float* scr = (LAS float*)(F.lds + F.wave * 16384);
    const int gw = F.vcu * NWAVES + F.wave, NGW = F.G * NWAVES;
    constexpr int I_W1 = 2 * 16 * 256, I_SQ = 2 * 3 * 512, I_G = 512, NITEMS = I_W1 + I_SQ + I_G;
    for (int it = gw; it < NITEMS; it += NGW) {
        if (it < I_W1) { const int l = it >> 12, r = it & 4095, kb = r >> 8, nb = r & 255;
            tr_item<0>(F.in[7] + (size_t)l * 1024 * 8192, 8192, 64 * kb, 32 * nb, (bf16_t*)(F.ws + WS_W1T) + (size_t)l * 8192 * 1024, 1024, 0, 0, scr, F.lane); }
        else if (it < I_W1 + I_SQ) { int r = it - I_W1; const int l = r / 1536; r %= 1536; const int which = r / 512; r %= 512; const int kb = r >> 5, nb = r & 31;
            if (which == 0) tr_item<1>(F.in[16] + (size_t)l * 1024 * 1024, 1024, 64 * kb, 32 * nb, (bf16_t*)(F.ws + WS_WABT) + (size_t)l * 1024 * 2048, 2048, 0, 0, scr, F.lane);
            else if (which == 1) tr_item<1>(F.in[17] + (size_t)l * 1024 * 1024, 1024, 64 * kb, 32 * nb, (bf16_t*)(F.ws + WS_WABT) + (size_t)l * 1024 * 2048, 2048, 1024, 0, scr, F.lane);
            else tr_item<2>(F.in[18] + (size_t)l * 1024 * 1024, 1024, 64 * kb, 32 * nb, (bf16_t*)(F.ws + WS_WOT) + (size_t)l * 1024 * 1024, 1024, 0, 0, scr, F.lane); }
        else { int r = it - I_W1 - I_SQ; const int mat = r >> 3; r &= 7; const int kb = r >> 2, nb = r & 3; const int l = mat >> 5, dir = (mat >> 4) & 1, isI = (mat >> 3) & 1, blk = mat & 7;
            const float* W = (isI ? F.in[13] : F.in[11]) + (size_t)((l * 2 + dir) * 8 + blk) * 128 * 128;
            tr_item<3>(W, 128, 64 * kb, 32 * nb, (bf16_t*)(F.ws + WS_GWT) + (size_t)l * 4096 * 128, 128, 0, 512 * blk + 128 * dir + 16 * isI, scr, F.lane); }
    }
}

__device__ __forceinline__ void norm_phase(Frame& F, int l, bool final) {
    F.ids();
    const int gw = F.vcu * NWAVES + F.wave, NGW = F.G * NWAVES;
    const float* MOD = (const float*)(F.ws + WS_MOD) + (size_t)l * 3 * 3072;
    const float* gsrc = final ? F.in[19] : F.in[6] + l * 1024;
    bf16_t* BIG = (bf16_t*)(F.ws + WS_BIG);
    const int nrows = final ? ML : M;
    f32x4 g4[4];
#pragma unroll
    for (int j = 0; j < 4; ++j) g4[j] = *(const f32x4*)(gsrc + 4 * F.lane + 256 * j);
    for (int row = gw; row < nrows; row += NGW) {
        const bool isctx = row >= ML;
        const float* src = (l == 0 && !final) ? (isctx ? F.in[2] + (size_t)(row - ML) * 1024 : F.in[0] + (size_t)row * 1024)
                                              : (isctx ? (const float*)(F.ws + WS_CTX1) + (size_t)(row - ML) * 1024 : F.out + (size_t)row * 1024);
        f32x4 v[4]; float ss = 0.f;
#pragma unroll
        for (int j = 0; j < 4; ++j) { v[j] = *(const f32x4*)(src + 4 * F.lane + 256 * j); ss += (v[j][0] * v[j][0] + v[j][1] * v[j][1]) + (v[j][2] * v[j][2] + v[j][3] * v[j][3]); }
        const float rstd = rsqrtf(wave_sum(ss, F.lane) * (1.0f / 1024.0f) + RMS_EPS);
        if (final) {
#pragma unroll
            for (int j = 0; j < 4; ++j) *(f32x4*)(F.out + (size_t)row * 1024 + 4 * F.lane + 256 * j) = v[j] * rstd * g4[j];
        } else {
            const int vi = isctx ? 2 : (row >> 13);
            const float* sh = MOD + vi * 3072; const float* scl = sh + 1024;
#pragma unroll
            for (int j = 0; j < 4; ++j) { const int cidx = 4 * F.lane + 256 * j;
                const f32x4 y = v[j] * rstd * g4[j]; const f32x4 h = y * (*(const f32x4*)(scl + cidx) + 1.0f) + *(const f32x4*)(sh + cidx);
                *(u32x2*)(BIG + (size_t)row * 2048 + 1024 + cidx) = pack4(h); }
        }
    }
}

__device__ __forceinline__ void carry_phase(Frame& F) {
    F.ids();
    const int gi = blockIdx.x * 512 + F.tid;
    if (gi >= NB * 2 * 1024) return;
    const int b = gi >> 11, d = (gi >> 10) & 1, ch = gi & 1023;
    const float* AGG = (const float*)(F.ws + WS_AGG); float* CARRY = (float*)(F.ws + WS_CARRY);
    float h = 0.f;
    for (int s = 0; s < 33; ++s) {
        const int tile = s == 0 ? 64 + b : (d == 0 ? 32 * b + (s - 1) : 32 * b + (32 - s));
        const f32x2 ab = *(const f32x2*)(AGG + ((size_t)(tile * 2 + d) * 1024 + ch) * 2);
        CARRY[(size_t)(tile * 2 + d) * 1024 + ch] = h;
        h = ab.x * h + ab.y;
    }
}

constexpr int N_PHASES = 16;
__global__ void __launch_bounds__(NWAVES * 64, 2) mk_fwd(Args args) {
    extern __shared__ __attribute__((aligned(16))) unsigned char lds[];
    const int wave_id = __builtin_amdgcn_readfirstlane((int)threadIdx.x >> 6);
    volatile LAS unsigned* MISC = (volatile LAS unsigned*)((LAS unsigned char*)lds + MISC_OFF);
    for (int u = threadIdx.x; u < 128; u += NWAVES * 64) MISC[u] = 0u;
    __syncthreads();
    XcdBarrier bar; bar.bar = (unsigned*)(args.ws + WS_CTL) + CW_BAR; bar.x = 0; bar.st = nullptr;
    if (!MK_PER_PHASE) bar = xcd_barrier_post((unsigned*)(args.ws + WS_CTL) + CW_BAR, MISC + 8);

    for (int ph = args.ph_lo; ph < args.ph_hi; ++ph) {
        CArgs* ka = (CArgs*)__builtin_amdgcn_kernarg_segment_ptr(); asm volatile("" : "+s"(ka));
        Frame F;
        F.lds = (LAS unsigned char*)lds;
        F.wave = wave_id; F.lane = 0; F.tid = 0;
        F.G = gridDim.x; { const int bx = blockIdx.x; F.vcu = (F.G % 8 == 0) ? (bx % 8) * (F.G / 8) + bx / 8 : bx; }
        F.in.ka = ka; F.out = ka->out; F.ws = ka->ws;
        LAS float* scr = (LAS float*)(F.lds + SCR_OFF);
        bf16_t* BIG = (bf16_t*)(F.ws + WS_BIG); bf16_t* XC = (bf16_t*)(F.ws + WS_XC); bf16_t* SZB = (bf16_t*)(F.ws + WS_SZB); bf16_t* RAT = (bf16_t*)(F.ws + WS_RAT); bf16_t* SMB = (bf16_t*)(F.ws + WS_SMB);
        float* CTX1 = (float*)(F.ws + WS_CTX1);
        if (ph == 0) { p0_prologue(F); }
        else if (ph == N_PHASES - 1) { norm_phase(F, 1, true); }
        else {
            const int l = (ph - 1) / 7, sub = (ph - 1) % 7;
            if (sub == 0) { norm_phase(F, l, false); }
            else if (sub == 1) {
                pg8::Gemm g{BIG + 1024, (const bf16_t*)(F.ws + WS_W1T) + (size_t)l * 8192 * 1024, 2048, 1024, 1024, 0, 0, 0, 0};
                pg8::Sched S; if (l == 0) S.init(64, 32, F.G, (int)blockIdx.x, 1, 64, 64, 0, 32); else S.init(64, 32, F.G, (int)blockIdx.x, 1, 8, 64, 16, 4);
                EpiG1 E{BIG, XC, SZB, RAT, SMB, F.in[8] + l * 3 * 1024, F.in[9] + l * 4 * 1024, F.in[10] + l * 1024, scr};
                pg8::gemm_phase<EpiG1>(F.lds, g, S, E, F.wave);
            } else if (sub == 2 || sub == 4) {
                pg8::Gemm g{XC, (const bf16_t*)(F.ws + WS_GWT) + (size_t)l * 4096 * 128, 1024, 128, 128, 0, 0, 1, 128};
                pg8::Sched S; S.init(66, 16, F.G, (int)blockIdx.x);
                if (sub == 2) { EpiS<0> E{XC, SZB, BIG, F.in[12] + l * 2048, F.in[14] + l * 2048, (const float*)(F.ws + WS_CLAM) + l * 2048, (float*)(F.ws + WS_AGG), (const float*)(F.ws + WS_CARRY), scr};
                    pg8::gemm_phase<EpiS<0>>(F.lds, g, S, E, F.wave); }
                else { EpiS<1> E{XC, SZB, BIG, F.in[12] + l * 2048, F.in[14] + l * 2048, (const float*)(F.ws + WS_CLAM) + l * 2048, (float*)(F.ws + WS_AGG), (const float*)(F.ws + WS_CARRY), scr};
                    pg8::gemm_phase<EpiS<1>>(F.lds, g, S, E, F.wave); }
            } else if (sub == 3) { carry_phase(F); }
            else if (sub == 5) {
                pg8::Gemm g{BIG, (const bf16_t*)(F.ws + WS_WABT) + (size_t)l * 1024 * 2048, 2048, 2048, 1024, 1024, 1024, 0, 0};
                pg8::Sched S; S.init(l == 0 ? 66 : 64, 4, F.G, (int)blockIdx.x, 2);
                EpiG2 E{RAT, SMB, XC};
                pg8::gemm_phase<EpiG2>(F.lds, g, S, E, F.wave);
            } else {
                pg8::Gemm g{XC, (const bf16_t*)(F.ws + WS_WOT) + (size_t)l * 1024 * 1024, 1024, 1024, 1024, 0, 0, 0, 0};
                pg8::Sched S; S.init(l == 0 ? 66 : 64, 4, F.G, (int)blockIdx.x);
                EpiG3 E{l == 0 ? F.in[0] : F.out, l == 0 ? F.in[2] : CTX1, F.out, CTX1, (const float*)(F.ws + WS_MOD) + (size_t)l * 3 * 3072};
                pg8::gemm_phase<EpiG3>(F.lds, g, S, E, F.wave);
            }
        }
        if (ph + 1 < args.ph_hi) { const int ln2 = fresh_lane(); xcd_barrier(bar, wave_id == 0 && ln2 == 0); }
    }
}

extern "C" void kernel_launch(void* const* d_in, const int* in_sizes, int n_in, void* d_out, int out_size, void* d_ws, size_t ws_size, hipStream_t stream) {
    static int grid = 0;
    if (grid == 0) {
        if (n_in != 20 || in_sizes[0] != ML * D || out_size != ML * D || ws_size < WS_END) {
            fprintf(stderr, "kernel_launch: unexpected shapes: n_in %d in0 %d out %d ws %zu (need %zu)\n", n_in, n_in > 0 ? in_sizes[0] : -1, out_size, ws_size, (size_t)WS_END); grid = -1; return; }
        int dev = 0, cus = 0, per_cu = 0;
        if (hipGetDevice(&dev) != hipSuccess || hipDeviceGetAttribute(&cus, hipDeviceAttributeMultiprocessorCount, dev) != hipSuccess) { grid = -1; return; }
        if (hipFuncSetAttribute((const void*)mk_fwd, hipFuncAttributeMaxDynamicSharedMemorySize, LDS_BYTES) != hipSuccess) { fprintf(stderr, "kernel_launch: hipFuncSetAttribute failed\n"); grid = -1; return; }
        if (hipOccupancyMaxActiveBlocksPerMultiprocessor(&per_cu, (const void*)mk_fwd, NWAVES * 64, LDS_BYTES) != hipSuccess || per_cu < 1) {
            fprintf(stderr, "kernel_launch: occupancy query reports %d workgroups per CU\n", per_cu); (void)hipGetLastError(); grid = -1; return; }
        grid = cus;
    }
    if (grid < 0) return;
    if (hipMemsetAsync((char*)d_ws + WS_CTL, 0, CTL_ZERO_BYTES, stream) != hipSuccess) return;
    Args a{};
    for (int i = 0; i < 20; ++i) a.in[i] = (const float*)d_in[i];
    a.out = (float*)d_out; a.ws = (unsigned char*)d_ws;
#if MK_PER_PHASE
    for (int ph = 0; ph < N_PHASES; ++ph) { a.ph_lo = ph; a.ph_hi = ph + 1; hipLaunchKernelGGL(mk_fwd, dim3(grid), dim3(NWAVES * 64), LDS_BYTES, stream, a); }
#else
    a.ph_lo = 0; a.ph_hi = N_PHASES;
    hipLaunchKernelGGL(mk_fwd, dim3(grid), dim3(NWAVES * 64), LDS_BYTES, stream, a);
#endif
    const hipError_t le = hipPeekAtLastError();
    if (le != hipSuccess) fprintf(stderr, "kernel_launch: launch failed: %s\n", hipGetErrorName(le));
}
```

```cpp
#include <hip/hip_runtime.h>
#include <cstdio>
#include <cstdint>

#ifndef MK_PER_PHASE
#define MK_PER_PHASE 0
#endif

#ifndef EXTRA_BARS
#define EXTRA_BARS 0
#endif
#ifndef DUP_MASK
#define DUP_MASK 0
#endif

#define LAS __attribute__((address_space(3)))
#define GAS __attribute__((address_space(1)))
typedef unsigned short bf16_t;
typedef short bf16x8 __attribute__((ext_vector_type(8)));
typedef float f32x4 __attribute__((ext_vector_type(4)));
typedef float f32x2 __attribute__((ext_vector_type(2)));
typedef unsigned u32x4 __attribute__((ext_vector_type(4)));
typedef unsigned u32x2 __attribute__((ext_vector_type(2)));
typedef GAS unsigned gu32;

constexpr int D = 1024, NB = 2, T = 8192, CT = 256, NL = 2, DIN = 8192;
constexpr int ML = NB * T;
constexpr int MC = NB * CT;
constexpr int M = ML + MC;
constexpr float RMS_EPS = 1e-6f;
constexpr float LOG2E = 1.4426950408889634f;

constexpr size_t MiB = 1u << 20;
constexpr size_t WS_CTL = 0, CTL_ZERO_BYTES = 4 * MiB;
constexpr size_t WS_MOD = 1 * MiB;
constexpr size_t WS_CLAM = WS_MOD + 128 * 1024;
constexpr size_t WS_CTX1 = 4 * MiB;
constexpr size_t WS_W1T = 6 * MiB;
constexpr size_t WS_WABT = 38 * MiB;
constexpr size_t WS_WOT = 46 * MiB;
constexpr size_t WS_GWT = 50 * MiB;
constexpr size_t WS_BIG = 52 * MiB;
constexpr size_t WS_XC = 118 * MiB;
constexpr size_t WS_SZB = 151 * MiB;
constexpr size_t WS_RAT = 184 * MiB;
constexpr size_t WS_SMB = 217 * MiB;
constexpr size_t WS_GRAN = 1 * MiB + 512 * 1024;
constexpr size_t GRAN_BYTES = 2 * MiB + 256 * 1024;
constexpr size_t WS_GWTC = 253 * MiB;
constexpr size_t WS_END = 255 * MiB;
static_assert(WS_CLAM + NL * 2 * 1024 * 4 <= WS_GRAN && WS_GRAN + GRAN_BYTES <= WS_CTX1 && (size_t)(3 * 33 * 16 * 128 + 66 * 256 * 4) * 8 <= GRAN_BYTES && WS_CTX1 >= CTL_ZERO_BYTES, "ws map");
static_assert((size_t)M * 1024 * 2 == 33 * MiB, "ws map");

constexpr int CW_BAR = 4096;
constexpr int CW_CG2CNT = 320, CW_CG3CNT = 384;
constexpr int CW_CTXCNT = 192;
constexpr int CW_PANCNT = 8192;
constexpr int CW_PTMO = 64;
constexpr int GR_N = 33 * 16 * 128;

constexpr int RING_BYTES = 131072;
constexpr int MISC_OFF = RING_BYTES;
constexpr int SCR_OFF = RING_BYTES + 512;
constexpr int LDS_BYTES = 147456;
constexpr int NWAVES = 8;

__device__ __forceinline__ unsigned cvt_pk_bf16(float lo, float hi) { unsigned r; asm volatile("v_cvt_pk_bf16_f32 %0, %1, %2" : "=v"(r) : "v"(lo), "v"(hi)); return r; }
__device__ __forceinline__ float bf_lo(unsigned w) { return __uint_as_float(w << 16); }
__device__ __forceinline__ float bf_hi(unsigned w) { return __uint_as_float(w & 0xffff0000u); }
__device__ __forceinline__ f32x4 unpack4(u32x2 w) { return (f32x4){bf_lo(w.x), bf_hi(w.x), bf_lo(w.y), bf_hi(w.y)}; }
__device__ __forceinline__ u32x2 pack4(f32x4 v) { u32x2 w; w.x = cvt_pk_bf16(v[0], v[1]); w.y = cvt_pk_bf16(v[2], v[3]); return w; }
__device__ __forceinline__ float sigmoidf_(float x) { return __builtin_amdgcn_rcpf(1.0f + __builtin_amdgcn_exp2f(-x * LOG2E)); }
__device__ __forceinline__ f32x4 exp2_4(f32x4 t) { return (f32x4){__builtin_amdgcn_exp2f(t[0]), __builtin_amdgcn_exp2f(t[1]), __builtin_amdgcn_exp2f(t[2]), __builtin_amdgcn_exp2f(t[3])}; }
__device__ __forceinline__ f32x4 rcp4(f32x4 t) { return (f32x4){__builtin_amdgcn_rcpf(t[0]), __builtin_amdgcn_rcpf(t[1]), __builtin_amdgcn_rcpf(t[2]), __builtin_amdgcn_rcpf(t[3])}; }
__device__ __forceinline__ f32x4 sqrt4(f32x4 t) { return (f32x4){__builtin_amdgcn_sqrtf(t[0]), __builtin_amdgcn_sqrtf(t[1]), __builtin_amdgcn_sqrtf(t[2]), __builtin_amdgcn_sqrtf(t[3])}; }
__device__ __forceinline__ float opaque_f(float x) { asm("" : "+s"(x)); return x; }
__device__ __forceinline__ f32x4 sigmoid4(f32x4 x) { return rcp4(exp2_4(x * opaque_f(-LOG2E)) + 1.0f); }
__device__ __forceinline__ f32x4 silu4(f32x4 x) { return x * sigmoid4(x); }
template <int CTRL> __device__ __forceinline__ float dppf(float old, float src) {
    return __builtin_bit_cast(float, __builtin_amdgcn_update_dpp(__builtin_bit_cast(int, old), __builtin_bit_cast(int, src), CTRL, 0xf, 0xf, false));
}
template <int CTRL> __device__ __forceinline__ f32x4 dpp4(f32x4 old, f32x4 s) { return (f32x4){dppf<CTRL>(old[0], s[0]), dppf<CTRL>(old[1], s[1]), dppf<CTRL>(old[2], s[2]), dppf<CTRL>(old[3], s[3])}; }
#define DPP_ROR(n) (0x120 + (n))
#define DPP_SHR(n) (0x110 + (n))
#define DPP_SHL(n) (0x100 + (n))
#define DPP_BCAST(n) (0x150 + (n))
__device__ __forceinline__ f32x4 sel4(bool c, f32x4 a, f32x4 b) { return c ? a : b; }
__device__ __forceinline__ int fresh_lane() { unsigned z; asm volatile("s_mov_b32 %0, 0" : "=s"(z)); return (int)__builtin_amdgcn_mbcnt_hi(~0u, __builtin_amdgcn_mbcnt_lo(~0u, z)); }
#define LDS_WAIT() asm volatile("s_waitcnt lgkmcnt(0)" ::: "memory")
#define VM_WAIT() asm volatile("s_waitcnt vmcnt(0)" ::: "memory")
#define WG_BAR() do { asm volatile("s_waitcnt lgkmcnt(0)" ::: "memory"); __builtin_amdgcn_s_barrier(); asm volatile("" ::: "memory"); } while (0)

namespace pg8 {
constexpr int BM = 256, BK = 64, HALF = 128, HTB = HALF * BK * 2, STAGE_BYTES = 8 * HTB, NXCD = 8;
#ifndef WGM_DEFAULT
#define WGM_DEFAULT 6
#endif
#ifndef WGM_G23
#define WGM_G23 4
#endif
constexpr int WGM_UNUSED = 0;
__host__ __device__ __forceinline__ int lds_byte(int r, int c) { const int st = (r >> 4) * 2 + (c >> 5), rr = r & 15, cc = c & 31, ob = rr * 64 + cc * 2; return st * 1024 + (ob ^ (((ob >> 9) & 1) << 5)); }
__host__ __device__ __forceinline__ void stage_rc(int b, int& R, int& C) { const int st = b / 1024, sb = b % 1024, swz = sb ^ (((sb >> 9) & 1) << 5); R = (st >> 1) * 16 + swz / 64; C = (st & 1) * 32 + (swz % 64) / 2; }

struct Unit { int pm, pn, kk, pos, bb, plo; };
struct Gemm {
    const bf16_t* A; const bf16_t* Bt; int lda, ldb, K; int a_kk, b_kk; int a_pn_shift, a_pn_mul; int a_perm;
    __device__ __forceinline__ const char* a_ptr(const Unit& u) const { return (const char*)(A + (size_t)u.pm * 256 * lda + (size_t)u.kk * a_kk + (size_t)(u.pn >> a_pn_shift) * a_pn_mul); }
    __device__ __forceinline__ const char* b_ptr(const Unit& u) const { return (const char*)(Bt + (size_t)u.pn * 256 * ldb + (size_t)u.kk * b_kk); }
};
struct Sched {
    int nM, nN, G, c, kdiv, nmain, extra_n, extra_pm0, extra_pn0, extra_npn, pass_dir, extra_first, list_off, extra_sh, late_n, late_r, wgm;
    __device__ __forceinline__ void init(int nM_, int nN_, int G_, int c_, int kdiv_ = 1, int extra_n_ = 0, int epm0 = 0, int epn0 = 0, int enpn = 1) {
        nM = nM_; nN = nN_; G = G_; c = c_; kdiv = kdiv_; nmain = nM * nN; extra_n = extra_n_; extra_pm0 = epm0; extra_pn0 = epn0; extra_npn = enpn; pass_dir = -1; extra_first = 0; list_off = -1; extra_sh = 31 - __builtin_clz((unsigned)enpn); late_n = 0; late_r = 0; wgm = WGM_DEFAULT; }
    __device__ __forceinline__ void init_pass(int G_, int c_, int dir) { init(0, 1, G_, c_); pass_dir = dir; }
    __device__ __forceinline__ bool next(int i, Unit& u) const {
        u.pos = 0; u.bb = 0; u.plo = 0;
        if (pass_dir >= 0) {
            const int L = i * G + c; if (L >= 32 * 16) return false;
            const int pos = (L >> 4) + 1, bb = L & 15, b = bb >> 3;
            u.pm = pass_dir == 0 ? 32 * b + pos - 1 : 32 * b + 32 - pos; u.pn = bb & 7; u.kk = 0;
            u.pos = pos; u.bb = bb; u.plo = ((i * G - bb + 15) >> 4) + 1; return true;
        }
        const int ti = (kdiv == 2) ? (i >> 1) : i; u.kk = (kdiv == 2) ? (i & 1) : 0;
        if (list_off >= 0) {
            const int e = ti * G + c - list_off; if (e < 0 || e >= extra_n) return false;
            u.pm = extra_pm0 + (e >> extra_sh); u.pn = extra_pn0 + (e & (extra_npn - 1)); return true;
        }
        long L = (long)ti * G + c;
        if (late_n > 0) {
            if (c < late_n) {
                if (i == 0) { u.pm = 64 + (c >> 2); u.pn = 16 + (c & 3); return true; }
                L = (long)late_r * (G - late_n) + (long)(i - 1) * G + c;
            } else L = i < late_r ? (long)i * (G - late_n) + (c - late_n) : (long)late_r * (G - late_n) + (long)(i - late_r) * G + c;
            if (L >= nmain) return false;
        }
        if (extra_first) {
            if (L < extra_n) { const int e = (int)L; u.pm = extra_pm0 + (e >> extra_sh); u.pn = extra_pn0 + (e & (extra_npn - 1)); return true; }
            L -= extra_n; if (L >= nmain) return false;
        }
        if (L < nmain) {
            int wgid = (int)L; { const int q = nmain / NXCD, r = nmain % NXCD, xcd = wgid % NXCD, off = wgid / NXCD; wgid = (xcd < r ? xcd * (q + 1) : r * (q + 1) + (xcd - r) * q) + off; }
            const int nig = wgm * nN, gid = wgid / nig, fm = gid * wgm, gsz = (nM - fm) < wgm ? (nM - fm) : wgm;
            u.pm = fm + ((wgid % nig) % gsz); u.pn = (wgid % nig) / gsz; return true;
        }
        const int e = (int)(L - nmain); if (e >= extra_n) return false;
        u.pm = extra_pm0 + (e >> extra_sh); u.pn = extra_pn0 + (e & (extra_npn - 1)); return true;
    }
};

template <class T, class = void> struct epi_after_drain { static constexpr bool value = false; };
template <class T> struct epi_after_drain<T, decltype((void)T::AFTER_DRAIN)> { static constexpr bool value = T::AFTER_DRAIN; };
template <class Epi>
__device__ __forceinline__ void gemm_phase(LAS unsigned char* lds, const Gemm g, const Sched& S, const Epi& E, int wave_) {
    const int tid_ = fresh_lane() + wave_ * 64;
    const int tid = tid_, wid = __builtin_amdgcn_readfirstlane(tid >> 6), lane = tid & 63, wr = wid >> 2, wc = wid & 3, fr = lane & 15, fq = lane >> 4;
    int K_ = g.K; asm volatile("" : "+s"(K_));
    const int K = K_, nt = K / BK;
    unsigned voffA, voffB;
    { int R, C; stage_rc(tid * 16, R, C); const int Rp = g.a_perm ? 4 * (R & 15) + (R >> 4) : R; voffA = (unsigned)(Rp * g.lda + C) * 2u; voffB = (unsigned)(R * g.ldb + C) * 2u; }
    const size_t qvoffA = (size_t)64 * g.lda * 2, qvoffB = (size_t)64 * g.ldb * 2;
    const size_t kstep = (size_t)(BK * 2);
    const size_t hstepA = (size_t)HALF * g.lda * 2, hstepB = (size_t)HALF * g.ldb * 2;
    const unsigned ldsw = (unsigned)wid * 1024u;
    const int aoff = lds_byte(wr * 64 + fr, fq * 8), boff = lds_byte(wc * 32 + fr, fq * 8);
#define PG8_SA(b, h) (((b) * 2 + (h)) * HTB)
#define PG8_SB(b, h) ((4 + (b) * 2 + (h)) * HTB)
#define PG8_STAGE(bufoff, gbase, voff) do { _Pragma("unroll") for (int _i = 0; _i < 2; ++_i) \
        __builtin_amdgcn_global_load_lds((const unsigned*)((const char*)(gbase) + (size_t)_i * q##voff + (voff)), (LAS unsigned*)(lds + (bufoff) + ldsw + _i * 8192), 16, 0, 0); } while (0)
#define PG8_LDA(dst, b, h) do { _Pragma("unroll") for (int m = 0; m < 4; ++m) _Pragma("unroll") for (int k = 0; k < 2; ++k) dst[m][k] = *(const LAS bf16x8*)(lds + PG8_SA(b, h) + aoff + m * 2048 + k * 1024); } while (0)
#define PG8_LDB(dst, b, h) do { _Pragma("unroll") for (int n = 0; n < 2; ++n) _Pragma("unroll") for (int k = 0; k < 2; ++k) dst[n][k] = *(const LAS bf16x8*)(lds + PG8_SB(b, h) + boff + n * 2048 + k * 1024); } while (0)
#define PG8_MMA(ai, bj, At, Bt) do { __builtin_amdgcn_s_setprio(1); _Pragma("unroll") for (int m = 0; m < 4; ++m) _Pragma("unroll") for (int n = 0; n < 2; ++n) _Pragma("unroll") for (int k = 0; k < 2; ++k) \
        acc[ai][bj][m][n] = __builtin_amdgcn_mfma_f32_16x16x32_bf16(Bt[n][k], At[m][k], acc[ai][bj][m][n], 0, 0, 0); __builtin_amdgcn_s_setprio(0); } while (0)
#define PG8_WAIT_V(n) asm volatile("s_waitcnt vmcnt(" #n ")" ::: "memory")
#define PG8_WAIT_L(n) asm volatile("s_waitcnt lgkmcnt(" #n ")" ::: "memory")
#define PG8_BAR __builtin_amdgcn_s_barrier()
#define PG8_SCHED __builtin_amdgcn_sched_barrier(0)
    Unit cur, nxt; int ui = 0;
    if (!S.next(0, cur)) return;
    f32x4 acc[2][2][4][2];
#pragma unroll
    for (int a = 0; a < 2; ++a)
#pragma unroll
        for (int b = 0; b < 2; ++b)
#pragma unroll
            for (int m = 0; m < 4; ++m)
#pragma unroll
                for (int n = 0; n < 2; ++n) acc[a][b][m][n] = (f32x4){0.f, 0.f, 0.f, 0.f};
    bf16x8 At[4][2], B0[2][2], B1[2][2];
    const char* cA = g.a_ptr(cur); const char* cB = g.b_ptr(cur);
    PG8_STAGE(PG8_SB(0, 0), cB, voffB); PG8_STAGE(PG8_SB(0, 1), cB + hstepB, voffB); PG8_STAGE(PG8_SA(0, 0), cA, voffA); PG8_STAGE(PG8_SA(0, 1), cA + hstepA, voffA);
    if (wr == 1) PG8_BAR;
    PG8_WAIT_V(2); PG8_BAR;
    PG8_STAGE(PG8_SB(1, 0), cB + kstep, voffB); PG8_STAGE(PG8_SA(1, 0), cA + kstep, voffA); PG8_STAGE(PG8_SB(1, 1), cB + hstepB + kstep, voffB);
    PG8_WAIT_V(6); PG8_BAR;
    for (;;) {
        const bool has_next = S.next(ui + 1, nxt);
        const char* nA = has_next ? g.a_ptr(nxt) : cA; const char* nB = has_next ? g.b_ptr(nxt) : cB;
        for (int t = 0; t < nt; t += 2) {
            const bool last = (t == nt - 2);
            const char* a1 = cA + (size_t)(t + 1) * kstep;
            const char* a2 = last ? nA : cA + (size_t)(t + 2) * kstep; const char* b2 = last ? nB : cB + (size_t)(t + 2) * kstep;
            const char* a3 = a2 + kstep; const char* b3 = b2 + kstep;
            PG8_LDB(B0, 0, 0); PG8_LDB(B1, 0, 1); PG8_SCHED; PG8_LDA(At, 0, 0); PG8_STAGE(PG8_SA(1, 1), a1 + hstepA, voffA);
            PG8_WAIT_V(8); PG8_WAIT_L(0); PG8_BAR; PG8_MMA(0, 0, At, B0); PG8_MMA(0, 1, At, B1); PG8_BAR; PG8_SCHED;
            PG8_LDA(At, 0, 1); PG8_STAGE(PG8_SB(0, 0), b2, voffB); PG8_STAGE(PG8_SB(0, 1), b2 + hstepB, voffB); PG8_STAGE(PG8_SA(0, 0), a2, voffA);
            PG8_WAIT_V(8); PG8_WAIT_L(0); PG8_BAR; PG8_MMA(1, 0, At, B0); PG8_MMA(1, 1, At, B1); PG8_BAR; PG8_SCHED;
            PG8_LDB(B0, 1, 0); PG8_LDB(B1, 1, 1); PG8_SCHED; PG8_LDA(At, 1, 0); PG8_STAGE(PG8_SA(0, 1), a2 + hstepA, voffA);
            PG8_WAIT_V(8); PG8_WAIT_L(0); PG8_BAR; PG8_MMA(0, 0, At, B0); PG8_MMA(0, 1, At, B1); PG8_BAR; PG8_SCHED;
            PG8_LDA(At, 1, 1); PG8_STAGE(PG8_SB(1, 0), b3, voffB); PG8_STAGE(PG8_SB(1, 1), b3 + hstepB, voffB); PG8_STAGE(PG8_SA(1, 0), a3, voffA);
            PG8_WAIT_V(8); PG8_WAIT_L(0); PG8_BAR; PG8_MMA(1, 0, At, B0); PG8_MMA(1, 1, At, B1); PG8_BAR; PG8_SCHED;
        }
        if (wr == 0) PG8_BAR;
        const int eln = fresh_lane();
        const int efr = eln & 15, efq = eln >> 4; int ewr = wr, ewc = wc; asm volatile("" : "+s"(ewr), "+s"(ewc));
        bool keep = false;
        if constexpr (!epi_after_drain<Epi>::value) keep = E(acc, cur, ewr, ewc, efr, efq);
        if (!has_next) break;
        if (!keep) {
#pragma unroll
            for (int a = 0; a < 2; ++a)
#pragma unroll
                for (int b = 0; b < 2; ++b)
#pragma unroll
                    for (int m = 0; m < 4; ++m)
#pragma unroll
                        for (int n = 0; n < 2; ++n) acc[a][b][m][n] = (f32x4){0.f, 0.f, 0.f, 0.f};
        }
        cur = nxt; cA = nA; cB = nB; ++ui;
        if (wr == 1) PG8_BAR;
    }
    PG8_WAIT_V(0);
    PG8_BAR;
    if constexpr (epi_after_drain<Epi>::value) { const int eln = fresh_lane(); int ewr = wr, ewc = wc; asm volatile("" : "+s"(ewr), "+s"(ewc)); E.final(acc, cur, ewr, ewc, eln, lds); }
#undef PG8_SA
#undef PG8_SB
#undef PG8_STAGE
#undef PG8_LDA
#undef PG8_LDB
#undef PG8_MMA
#undef PG8_WAIT_V
#undef PG8_WAIT_L
#undef PG8_BAR
#undef PG8_SCHED
}

template <class Epi>
__device__ __forceinline__ void pass_phase(LAS unsigned char* lds, const Gemm g, const Sched& S, const Epi& E, int wave_) {
    const int tid = fresh_lane() + wave_ * 64;
    const int wid = __builtin_amdgcn_readfirstlane(tid >> 6), lane = tid & 63, wr = wid >> 2, wc = wid & 3, fr = lane & 15, fq = lane >> 4;
    unsigned voffA, voffB;
    { int R, C; stage_rc(tid * 16, R, C); voffA = (unsigned)((4 * (R & 15) + (R >> 4)) * g.lda + C) * 2u; voffB = (unsigned)(R * g.ldb + C) * 2u; }
    const size_t qvoffA = (size_t)64 * g.lda * 2, qvoffB = (size_t)64 * g.ldb * 2;
    const size_t kstep = (size_t)(BK * 2), hstepA = (size_t)HALF * g.lda * 2, hstepB = (size_t)HALF * g.ldb * 2;
    const unsigned ldsw = (unsigned)wid * 1024u;
    const int aoff = lds_byte(wr * 64 + fr, fq * 8), boff = lds_byte(wc * 32 + fr, fq * 8);
#define PP_SA(b, h) (((b) * 2 + (h)) * HTB)
#define PP_SB(b, h) ((4 + (b) * 2 + (h)) * HTB)
#define PP_STAGE(bufoff, gbase, voff) do { _Pragma("unroll") for (int _i = 0; _i < 2; ++_i) \
        __builtin_amdgcn_global_load_lds((const unsigned*)((const char*)(gbase) + (size_t)_i * q##voff + (voff)), (LAS unsigned*)(lds + (bufoff) + ldsw + _i * 8192), 16, 0, 0); } while (0)
#define PP_STAGE_A(ap) do { PP_STAGE(PP_SA(0, 0), (ap), voffA); PP_STAGE(PP_SA(0, 1), (ap) + hstepA, voffA); PP_STAGE(PP_SA(1, 0), (ap) + kstep, voffA); PP_STAGE(PP_SA(1, 1), (ap) + hstepA + kstep, voffA); } while (0)
#define PP_STAGE_B(bp) do { PP_STAGE(PP_SB(0, 0), (bp), voffB); PP_STAGE(PP_SB(0, 1), (bp) + hstepB, voffB); PP_STAGE(PP_SB(1, 0), (bp) + kstep, voffB); PP_STAGE(PP_SB(1, 1), (bp) + hstepB + kstep, voffB); } while (0)
    Unit cur, nxt; int ui = 0;
    if (!S.next(0, cur)) return;
    PP_STAGE_B(g.b_ptr(cur)); PP_STAGE_A(g.a_ptr(cur));
    for (;;) {
        const bool has_next = S.next(ui + 1, nxt);
        asm volatile("s_waitcnt vmcnt(0)" ::: "memory"); __builtin_amdgcn_s_barrier(); asm volatile("" ::: "memory");
        f32x4 acc[2][2][4][2];
#pragma unroll
        for (int a = 0; a < 2; ++a)
#pragma unroll
            for (int b = 0; b < 2; ++b)
#pragma unroll
                for (int m = 0; m < 4; ++m)
#pragma unroll
                    for (int n = 0; n < 2; ++n) acc[a][b][m][n] = (f32x4){0.f, 0.f, 0.f, 0.f};
#pragma unroll
        for (int b = 0; b < 2; ++b) {
            bf16x8 B0[2][2], B1[2][2];
#pragma unroll
            for (int n = 0; n < 2; ++n)
#pragma unroll
                for (int k = 0; k < 2; ++k) { B0[n][k] = *(const LAS bf16x8*)(lds + PP_SB(b, 0) + boff + n * 2048 + k * 1024); B1[n][k] = *(const LAS bf16x8*)(lds + PP_SB(b, 1) + boff + n * 2048 + k * 1024); }
#pragma unroll
            for (int h = 0; h < 2; ++h) {
                bf16x8 At[4][2];
#pragma unroll
                for (int m = 0; m < 4; ++m)
#pragma unroll
                    for (int k = 0; k < 2; ++k) At[m][k] = *(const LAS bf16x8*)(lds + PP_SA(b, h) + aoff + m * 2048 + k * 1024);
#pragma unroll
                for (int m = 0; m < 4; ++m)
#pragma unroll
                    for (int n = 0; n < 2; ++n)
#pragma unroll
                        for (int k = 0; k < 2; ++k) { acc[h][0][m][n] = __builtin_amdgcn_mfma_f32_16x16x32_bf16(B0[n][k], At[m][k], acc[h][0][m][n], 0, 0, 0);
                                                      acc[h][1][m][n] = __builtin_amdgcn_mfma_f32_16x16x32_bf16(B1[n][k], At[m][k], acc[h][1][m][n], 0, 0, 0); }
            }
        }
        struct AfterGates { LAS unsigned char* lds; const char* nA; const char* nB; unsigned voffA, voffB, ldsw; size_t qvoffA, qvoffB, kstep, hstepA, hstepB; bool stage_a, stage_b;
            __device__ __forceinline__ void operator()() const {
                asm volatile("s_waitcnt lgkmcnt(0)" ::: "memory"); __builtin_amdgcn_s_barrier(); asm volatile("" ::: "memory");
                if (stage_b) PP_STAGE_B(nB);
                if (stage_a) PP_STAGE_A(nA);
            } };
        const AfterGates ag{lds, has_next ? g.a_ptr(nxt) : nullptr, has_next ? g.b_ptr(nxt) : nullptr, voffA, voffB, ldsw, qvoffA, qvoffB, kstep, hstepA, hstepB, has_next, has_next && (nxt.pn != cur.pn)};
        int eln = fresh_lane(); const int efr = eln & 15, efq = eln >> 4; int ewr = wr, ewc = wc; asm volatile("" : "+s"(ewr), "+s"(ewc));
        E.run(acc, cur, ewr, ewc, efr, efq, ag);
        if (!has_next) break;
        cur = nxt; ++ui;
    }
    asm volatile("s_waitcnt vmcnt(0)" ::: "memory"); __builtin_amdgcn_s_barrier();
#undef PP_SA
#undef PP_SB
#undef PP_STAGE
#undef PP_STAGE_A
#undef PP_STAGE_B
}
}
using pg8::Unit;
typedef f32x4 Acc[2][2][4][2];

struct EpiG1 {
    bf16_t* BIG; bf16_t* XC; bf16_t* SZB; bf16_t* RAT; bf16_t* SMB;
    const float* w3; const float* w4; const float* b4;
    LAS float* scr;
    unsigned* ctxcnt;
    __device__ __forceinline__ bool operator()(Acc& acc, const Unit& u, int wr, int wc, int fr, int fq) const {
        const int pm = u.pm, pn = u.pn;
        const bool isctx = pm >= 64;
        const unsigned row0 = (unsigned)pm * 256 + wr * 64 + 4 * fr;
        const f32x4 zero4 = (f32x4){0.f, 0.f, 0.f, 0.f};
        if (pn < 16) {
            const int ch0 = 64 * pn + 16 * wc + 4 * fq;
            const f32x4 w0 = *(const f32x4*)(w3 + ch0), w1 = *(const f32x4*)(w3 + 1024 + ch0), w2 = *(const f32x4*)(w3 + 2048 + ch0);
#pragma unroll
            for (int ai = 0; ai < 2; ++ai)
#pragma unroll
                for (int m = 0; m < 4; ++m) acc[ai][0][m][0] = acc[ai][0][m][0] * acc[ai][0][m][1];
            const int col = 16 * wc + 4 * fq;
            if (isctx) {
#pragma unroll
                for (int ai = 0; ai < 2; ++ai) { const int seg = 2 * ai + wr;
                    if (fr == 0) *(LAS f32x4*)(scr + (seg * 2 + 0) * 64 + col) = acc[ai][0][0][0];
                    if (fr == 15) *(LAS f32x4*)(scr + (seg * 2 + 1) * 64 + col) = acc[ai][0][3][0]; }
                WG_BAR();
            }
#pragma unroll
            for (int ai = 0; ai < 2; ++ai) {
                const int seg = 2 * ai + wr;
                f32x4 hp = zero4, hn = zero4;
                if (isctx) { if (seg > 0) hp = *(const LAS f32x4*)(scr + ((seg - 1) * 2 + 1) * 64 + col); if (seg < 3) hn = *(const LAS f32x4*)(scr + ((seg + 1) * 2 + 0) * 64 + col); }
                const f32x4 pl = dpp4<DPP_SHR(1)>(hp, acc[ai][0][3][0]);
                const f32x4 nf = dpp4<DPP_SHL(1)>(hn, acc[ai][0][0][0]);
#pragma unroll
                for (int m = 0; m < 4; ++m) {
                    const f32x4 prev = m > 0 ? acc[ai][0][m > 0 ? m - 1 : 0][0] : pl;
                    const f32x4 next = m < 3 ? acc[ai][0][m < 3 ? m + 1 : 3][0] : nf;
                    const f32x4 cv = w0 * prev + w1 * acc[ai][0][m][0] + w2 * next;
                    const f32x4 y = acc[ai][1][m][0] * cv * silu4(acc[ai][1][m][1]);
                    *(u32x2*)(BIG + (size_t)(row0 + ai * 128 + m) * 2048 + ch0) = pack4(y);
                }
            }
            if (isctx) WG_BAR();
        } else if (pn < 20) {
            if (isctx) {
#pragma unroll
                for (int ai = 0; ai < 2; ++ai) { const int seg = 2 * ai + wr;
#pragma unroll
                    for (int bj = 0; bj < 2; ++bj)
#pragma unroll
                        for (int n = 0; n < 2; ++n) { const int col = 128 * bj + 32 * wc + 16 * n + 4 * fq;
                            if (fr == 0) *(LAS f32x4*)(scr + (seg * 3 + 0) * 256 + col) = acc[ai][bj][0][n];
                            if (fr == 15) *(LAS f32x4*)(scr + (seg * 3 + 1) * 256 + col) = acc[ai][bj][2][n];
                            if (fr == 15) *(LAS f32x4*)(scr + (seg * 3 + 2) * 256 + col) = acc[ai][bj][3][n]; } }
                WG_BAR();
            }
#pragma unroll
            for (int bj = 0; bj < 2; ++bj) {
                const int ch0 = 256 * (pn - 16) + 128 * bj + 32 * wc + 8 * fq;
#pragma unroll
                for (int ai = 0; ai < 2; ++ai) {
                    const int seg = 2 * ai + wr;
                    u32x2 pk[4];
#pragma unroll
                    for (int n = 0; n < 2; ++n) {
                        const int ch = ch0 + 4 * n, col = 128 * bj + 32 * wc + 16 * n + 4 * fq;
                        const f32x4 k0 = *(const f32x4*)(w4 + ch), k1 = *(const f32x4*)(w4 + 1024 + ch), k2 = *(const f32x4*)(w4 + 2048 + ch), k3 = *(const f32x4*)(w4 + 3072 + ch), kb = *(const f32x4*)(b4 + ch);
                        f32x4 hp1 = zero4, hp2 = zero4, hn1 = zero4;
                        if (isctx) {
                            if (seg > 0) { hp2 = *(const LAS f32x4*)(scr + ((seg - 1) * 3 + 1) * 256 + col); hp1 = *(const LAS f32x4*)(scr + ((seg - 1) * 3 + 2) * 256 + col); }
                            if (seg < 3) hn1 = *(const LAS f32x4*)(scr + ((seg + 1) * 3 + 0) * 256 + col); }
                        const f32x4 s3 = dpp4<DPP_SHR(1)>(hp1, acc[ai][bj][3][n]), s2 = dpp4<DPP_SHR(1)>(hp2, acc[ai][bj][2][n]);
                        const f32x4 nx = dpp4<DPP_SHL(1)>(hn1, acc[ai][bj][0][n]);
#pragma unroll
                        for (int m = 0; m < 4; ++m) {
                            const f32x4 x = acc[ai][bj][m][n];
                            const f32x4 p1 = m > 0 ? acc[ai][bj][m > 0 ? m - 1 : 0][n] : s3;
                            const f32x4 p2 = m > 1 ? acc[ai][bj][m > 1 ? m - 2 : 0][n] : (m == 1 ? s3 : s2);
                            const f32x4 n1 = m < 3 ? acc[ai][bj][m < 3 ? m + 1 : 3][n] : nx;
                            const f32x4 o = k0 * p2 + k1 * p1 + k2 * x + k3 * n1 + kb;
                            if (n == 0) pk[m] = pack4(o);
                            else { const u32x2 b = pack4(o); *(u32x4*)(XC + (size_t)(row0 + ai * 128 + m) * 1024 + ch0) = (u32x4){pk[m].x, pk[m].y, b.x, b.y}; }
                        }
                    }
                }
            }
            if (isctx) WG_BAR();
        } else if (pn < 24) {
#pragma unroll
            for (int bj = 0; bj < 2; ++bj) { const int ch0 = 256 * (pn - 20) + 128 * bj + 32 * wc + 8 * fq;
#pragma unroll
                for (int ai = 0; ai < 2; ++ai)
#pragma unroll
                    for (int m = 0; m < 4; ++m) { const u32x2 a = pack4(silu4(acc[ai][bj][m][0])), b = pack4(silu4(acc[ai][bj][m][1]));
                        *(u32x4*)(SZB + (size_t)(row0 + ai * 128 + m) * 1024 + ch0) = (u32x4){a.x, a.y, b.x, b.y}; } }
        } else {
            const int ch0 = 128 * (pn - 24) + 32 * wc + 8 * fq;
#pragma unroll
            for (int ai = 0; ai < 2; ++ai)
#pragma unroll
                for (int m = 0; m < 4; ++m) {
                    const float nl = opaque_f(-LOG2E);
                    const f32x4 pa0 = exp2_4(acc[ai][0][m][0] * nl) + 1.0f, pa1 = exp2_4(acc[ai][0][m][1] * nl) + 1.0f, pb0 = exp2_4(acc[ai][1][m][0] * nl) + 1.0f, pb1 = exp2_4(acc[ai][1][m][1] * nl) + 1.0f;
                    const f32x4 sb0 = rcp4(pb0), sb1 = rcp4(pb1);
                    const f32x4 q0 = pb0 * rcp4(pa0), q1 = pb1 * rcp4(pa1);
                    const size_t off = (size_t)(row0 + ai * 128 + m) * 1024 + ch0;
                    { const u32x2 a = pack4(q0), b = pack4(q1); *(u32x4*)(RAT + off) = (u32x4){a.x, a.y, b.x, b.y}; }
                    { const u32x2 a = pack4(sb0), b = pack4(sb1); *(u32x4*)(SMB + off) = (u32x4){a.x, a.y, b.x, b.y}; }
                }
        }
        if (isctx) {
            asm volatile("s_waitcnt vmcnt(0)" ::: "memory"); WG_BAR();
            if (wr == 0 && wc == 0 && fq == 0 && fr == 0) { __builtin_amdgcn_fence(__ATOMIC_RELEASE, "agent"); asm volatile("s_waitcnt vmcnt(0)" ::: "memory");
                __hip_atomic_fetch_add(ctxcnt, 1u, __ATOMIC_RELAXED, __HIP_MEMORY_SCOPE_AGENT); }
        }
        return false;
    }
};

typedef unsigned long long u64;
__device__ __forceinline__ void gr_store(u64* p, unsigned epoch, float v) { __hip_atomic_store(p, ((u64)epoch << 32) | (u64)__float_as_uint(v), __ATOMIC_RELAXED, __HIP_MEMORY_SCOPE_AGENT); }
__device__ __forceinline__ u64 gr_load(const u64* p) { return __hip_atomic_load(p, __ATOMIC_RELAXED, __HIP_MEMORY_SCOPE_AGENT); }
template <int DIR> struct EpiP {
    const bf16_t* XC; const bf16_t* SZB; bf16_t* BIG;
    const float* br; const float* bi; const float* clam;
    u64* gran; unsigned* tmo; unsigned epoch;
    LAS float* scr;
    const LAS unsigned char* xlds;
    template <class AfterGates> __device__ __forceinline__ bool run(Acc& acc, const Unit& u, int wr, int wc, int fr, int fq, const AfterGates& after_gates) const {
        const int pm = u.pm, blk = u.pn;
        const int cl = 32 * wc + 8 * fq; const unsigned chb = 128 * blk + cl;
        const unsigned row0 = (unsigned)pm * 256 + wr * 64 + 4 * fr;
        const int tq = (wr * 4 + wc) * 64 + fq * 16 + fr;
        u32x4 xw[2][4];
#pragma unroll
        for (int ai = 0; ai < 2; ++ai)
#pragma unroll
            for (int m = 0; m < 4; ++m) xw[ai][m] = *(const LAS u32x4*)(xlds + ((wc >> 1) * 2 + ai) * pg8::HTB + pg8::lds_byte(wr * 64 + 16 * m + fr, cl & 63));
        const float nl2e = opaque_f(-LOG2E), m1 = opaque_f(-1.0f);
#pragma unroll
        for (int n = 0; n < 2; ++n) {
            const int ch0 = chb + 4 * n;
            const f32x4 brv = *(const f32x4*)(br + ch0) * (-LOG2E), biv = *(const f32x4*)(bi + ch0) * (-LOG2E);
            const f32x4 cv = *(const f32x4*)(clam + ch0) * LOG2E;
#pragma unroll
            for (int ai = 0; ai < 2; ++ai)
#pragma unroll
                for (int m = 0; m < 4; ++m) {
                    const f32x4 x = unpack4(n == 0 ? (u32x2){xw[ai][m].x, xw[ai][m].y} : (u32x2){xw[ai][m].z, xw[ai][m].w});
                    const f32x4 tr = acc[ai][0][m][n] * nl2e + brv, ti = acc[ai][1][m][n] * nl2e + biv;
                    const f32x4 r = rcp4(exp2_4(tr) + 1.0f), ig = rcp4(exp2_4(ti) + 1.0f);
                    const f32x4 a = exp2_4(cv * r);
                    acc[ai][0][m][n] = a; acc[ai][1][m][n] = sqrt4((a * a) * m1 + 1.0f) * (ig * x);
                    __builtin_amdgcn_sched_barrier(0);
                }
        }
        after_gates();
#define SCAN_STEP(SH) \
        "v_fmac_f32_dpp %0, %0, %4 " SH " row_mask:0xf bank_mask:0xf\n\tv_fmac_f32_dpp %1, %1, %5 " SH " row_mask:0xf bank_mask:0xf\n\t" \
        "v_fmac_f32_dpp %2, %2, %6 " SH " row_mask:0xf bank_mask:0xf\n\tv_fmac_f32_dpp %3, %3, %7 " SH " row_mask:0xf bank_mask:0xf\n\t" \
        "v_mul_f32_dpp %4, %4, %4 " SH " row_mask:0xf bank_mask:0xf\n\tv_mul_f32_dpp %5, %5, %5 " SH " row_mask:0xf bank_mask:0xf\n\t" \
        "v_mul_f32_dpp %6, %6, %6 " SH " row_mask:0xf bank_mask:0xf\n\tv_mul_f32_dpp %7, %7, %7 " SH " row_mask:0xf bank_mask:0xf\n\t"
#define SCAN_CARRY(BC) \
        "v_fmac_f32_dpp %0, %8, %4 " BC " row_mask:0xf bank_mask:0xf\n\tv_fmac_f32_dpp %1, %9, %5 " BC " row_mask:0xf bank_mask:0xf\n\t" \
        "v_fmac_f32_dpp %2, %10, %6 " BC " row_mask:0xf bank_mask:0xf\n\tv_fmac_f32_dpp %3, %11, %7 " BC " row_mask:0xf bank_mask:0xf\n\t" \
        "v_mul_f32_dpp %4, %12, %4 " BC " row_mask:0xf bank_mask:0xf\n\tv_mul_f32_dpp %5, %13, %5 " BC " row_mask:0xf bank_mask:0xf\n\t" \
        "v_mul_f32_dpp %6, %14, %6 " BC " row_mask:0xf bank_mask:0xf\n\tv_mul_f32_dpp %7, %15, %7 " BC " row_mask:0xf bank_mask:0xf\n\t"
#define SCAN_OUT(A, L) "+v"(L[0]), "+v"(L[1]), "+v"(L[2]), "+v"(L[3]), "+v"(A[0]), "+v"(A[1]), "+v"(A[2]), "+v"(A[3])
#define SCAN_IN(A, L) "v"(L[0]), "v"(L[1]), "v"(L[2]), "v"(L[3]), "v"(A[0]), "v"(A[1]), "v"(A[2]), "v"(A[3])
#pragma unroll
        for (int ai = 0; ai < 2; ++ai) {
#pragma unroll
            for (int n = 0; n < 2; ++n) {
                if constexpr (DIR == 0) {
#pragma unroll
                    for (int m = 1; m < 4; ++m) { acc[ai][1][m][n] = acc[ai][0][m][n] * acc[ai][1][m - 1][n] + acc[ai][1][m][n]; acc[ai][0][m][n] = acc[ai][0][m][n] * acc[ai][0][m - 1][n]; }
                    asm volatile("s_nop 1\n\t" SCAN_STEP("row_shr:1") SCAN_STEP("row_shr:2") SCAN_STEP("row_shr:4") SCAN_STEP("row_shr:8") "s_nop 1" : SCAN_OUT(acc[ai][0][3][n], acc[ai][1][3][n]));
#pragma unroll
                    for (int m = 0; m < 3; ++m)
                        asm volatile("s_nop 1\n\t" SCAN_CARRY("row_shr:1") "s_nop 1" : SCAN_OUT(acc[ai][0][m][n], acc[ai][1][m][n]) : SCAN_IN(acc[ai][0][3][n], acc[ai][1][3][n]));
                } else {
#pragma unroll
                    for (int m = 2; m >= 0; --m) { acc[ai][1][m][n] = acc[ai][0][m][n] * acc[ai][1][m + 1][n] + acc[ai][1][m][n]; acc[ai][0][m][n] = acc[ai][0][m][n] * acc[ai][0][m + 1][n]; }
                    asm volatile("s_nop 1\n\t" SCAN_STEP("row_shl:1") SCAN_STEP("row_shl:2") SCAN_STEP("row_shl:4") SCAN_STEP("row_shl:8") "s_nop 1" : SCAN_OUT(acc[ai][0][0][n], acc[ai][1][0][n]));
#pragma unroll
                    for (int m = 1; m < 4; ++m)
                        asm volatile("s_nop 1\n\t" SCAN_CARRY("row_shl:1") "s_nop 1" : SCAN_OUT(acc[ai][0][m][n], acc[ai][1][m][n]) : SCAN_IN(acc[ai][0][0][n], acc[ai][1][0][n]));
                }
                const int seg = 2 * ai + wr;
                if (fr == (DIR == 0 ? 15 : 0)) {
#pragma unroll
                    for (int j = 0; j < 4; ++j) *(LAS f32x2*)(scr + (seg * 128 + cl + 4 * n + j) * 2) = (f32x2){acc[ai][0][DIR == 0 ? 3 : 0][n][j], acc[ai][1][DIR == 0 ? 3 : 0][n][j]};
                }
            }
        }
#undef SCAN_STEP
#undef SCAN_CARRY
#undef SCAN_OUT
#undef SCAN_IN
        u32x4 hfw[4], zw[4];
        if constexpr (DIR == 1) {
#pragma unroll
            for (int m = 0; m < 4; ++m) { const unsigned r = row0 + m; hfw[m] = *(const u32x4*)(BIG + (r * 2048u + 1024u + chb)); zw[m] = *(const u32x4*)(SZB + (r * 1024u + chb)); }
        }
        WG_BAR();
        {
            LAS float* part = scr + 1024; LAS float* car = scr + 2048;
            const int c = tq & 127, g = tq >> 7, pos = u.pos, npre = pos - u.plo;
            u64* const gA = gran + (size_t)u.bb * 128 + c; u64* const gB = gA + GR_N; u64* const gP = gA + 2 * GR_N;
            float At = 1.f, Bt = 0.f; f32x2 tb[4];
            if (tq < 128) {
#pragma unroll
                for (int s = 0; s < 4; ++s) { const int seg = DIR == 0 ? s : 3 - s; tb[s] = *(const LAS f32x2*)(scr + (seg * 128 + c) * 2); Bt = tb[s].x * Bt + tb[s].y; At = At * tb[s].x; }
                gr_store(gA + (size_t)pos * 2048, epoch, At); gr_store(gB + (size_t)pos * 2048, epoch, Bt);
            }
            float Ap = 1.f, Bp = 0.f, hbase = 0.f;
            {
                u64 ga[4], gb[4]; u64 gp = 0; const bool needp = (g == 0) && (u.plo > 0);
                unsigned spins = 0;
                for (;;) {
                    bool ok = true;
#pragma unroll
                    for (int i = 0; i < 4; ++i) { const int k = 4 * g + i; if (k < npre) { ga[i] = gr_load(gA + (size_t)(pos - 1 - k) * 2048); gb[i] = gr_load(gB + (size_t)(pos - 1 - k) * 2048); } else { ga[i] = 0; gb[i] = 0; } }
                    if (needp) gp = gr_load(((DIR == 1 && u.plo == 1) ? gA : gP) + (size_t)(u.plo - 1) * 2048);
#pragma unroll
                    for (int i = 0; i < 4; ++i) { const int k = 4 * g + i; if (k < npre) ok = ok && ((unsigned)(ga[i] >> 32) == epoch) && ((unsigned)(gb[i] >> 32) == epoch); }
                    if (needp) ok = ok && ((unsigned)(gp >> 32) == epoch);
                    if (ok) break;
                    __builtin_amdgcn_s_sleep(2);
                    if ((++spins & 63u) == 0u) { if (__hip_atomic_load(tmo, __ATOMIC_RELAXED, __HIP_MEMORY_SCOPE_AGENT) != 0u) break; if (spins > (1u << 16)) { __hip_atomic_store(tmo, 1u, __ATOMIC_RELAXED, __HIP_MEMORY_SCOPE_AGENT); break; } }
                }
#pragma unroll
                for (int i = 0; i < 4; ++i) { const int k = 4 * g + i; if (k < npre) { Bp = Ap * __uint_as_float((unsigned)gb[i]) + Bp; Ap = Ap * __uint_as_float((unsigned)ga[i]); } }
                if (needp) hbase = __uint_as_float((unsigned)gp);
            }
            *(LAS f32x2*)(part + (g * 128 + c) * 2) = (f32x2){Ap, Bp};
            WG_BAR();
            if (tq < 128) {
                float Aa = 1.f, Ba = 0.f;
#pragma unroll
                for (int g2 = 0; g2 < 4; ++g2) { const f32x2 p = *(const LAS f32x2*)(part + (g2 * 128 + c) * 2); Ba = Aa * p.y + Ba; Aa = Aa * p.x; }
                float h = Aa * hbase + Ba;
                gr_store(gP + (size_t)pos * 2048, epoch, At * h + Bt);
#pragma unroll
                for (int s = 0; s < 4; ++s) { const int seg = DIR == 0 ? s : 3 - s; car[seg * 128 + c] = h; h = tb[s].x * h + tb[s].y; }
            }
            WG_BAR();
#pragma unroll
            for (int ai = 0; ai < 2; ++ai) {
                const int seg = 2 * ai + wr;
                const f32x4 hs0 = *(const LAS f32x4*)(car + seg * 128 + cl), hs1 = *(const LAS f32x4*)(car + seg * 128 + cl + 4);
#pragma unroll
                for (int m = 0; m < 4; ++m) {
                    const unsigned r = row0 + ai * 128 + m;
                    f32x4 y0 = acc[ai][0][m][0] * hs0 + acc[ai][1][m][0], y1 = acc[ai][0][m][1] * hs1 + acc[ai][1][m][1];
                    if constexpr (DIR == 1) { y0 = (y0 + unpack4((u32x2){hfw[m].x, hfw[m].y})) * unpack4((u32x2){zw[m].x, zw[m].y}); y1 = (y1 + unpack4((u32x2){hfw[m].z, hfw[m].w})) * unpack4((u32x2){zw[m].z, zw[m].w}); }
                    const u32x2 p0 = pack4(y0), p1 = pack4(y1);
                    *(u32x4*)(BIG + (r * 2048u + 1024u + chb)) = (u32x4){p0.x, p0.y, p1.x, p1.y};
                }
                if constexpr (DIR == 1) { if (ai == 0) {
#pragma unroll
                    for (int m = 0; m < 4; ++m) { const unsigned r = row0 + 128 + m; hfw[m] = *(const u32x4*)(BIG + (r * 2048u + 1024u + chb)); zw[m] = *(const u32x4*)(SZB + (r * 1024u + chb)); } } }
            }
        }
        WG_BAR();
        return false;
    }
};

struct EpiC {
    const bf16_t* XC; const bf16_t* SZB; bf16_t* BIG;
    const float* br; const float* bi; const float* clam;
    u64* gran; unsigned epochF;
    LAS float* scr;
    __device__ __forceinline__ bool operator()(Acc& acc, const Unit& u, int wr, int wc, int fr, int fq) const {
        const int pm = u.pm, pn = u.pn;
        const int cl = 16 * wc + 4 * fq, ch0 = 64 * pn + cl;
        const unsigned row0 = (unsigned)pm * 256 + wr * 64 + fr;
        const f32x4 one4 = (f32x4){1.f, 1.f, 1.f, 1.f}, zero4 = (f32x4){0.f, 0.f, 0.f, 0.f};
        const int tq = (wr * 4 + wc) * 64 + fq * 16 + fr;
        constexpr int MODE = 1; const float cin = 0.f;
        u32x2 xw[2][4];
#pragma unroll
        for (int ai = 0; ai < 2; ++ai)
#pragma unroll
            for (int m = 0; m < 4; ++m) xw[ai][m] = *(const u32x2*)(XC + (size_t)(row0 + ai * 128 + m * 16) * 1024 + ch0);
        const float nl2e = opaque_f(-LOG2E), m1 = opaque_f(-1.0f);
#pragma unroll
        for (int d = 0; d < 2; ++d) {
            const f32x4 brv = *(const f32x4*)(br + d * 1024 + ch0) * (-LOG2E), biv = *(const f32x4*)(bi + d * 1024 + ch0) * (-LOG2E);
            const f32x4 cv = *(const f32x4*)(clam + d * 1024 + ch0) * LOG2E;
#pragma unroll
            for (int ai = 0; ai < 2; ++ai)
#pragma unroll
                for (int m = 0; m < 4; ++m) {
                    const f32x4 x = unpack4(xw[ai][m]);
                    const f32x4 tr = acc[ai][d][m][0] * nl2e + brv, ti = acc[ai][d][m][1] * nl2e + biv;
                    const f32x4 r = rcp4(exp2_4(tr) + 1.0f), ig = rcp4(exp2_4(ti) + 1.0f);
                    const f32x4 a = exp2_4(cv * r);
                    acc[ai][d][m][0] = a; acc[ai][d][m][1] = sqrt4((a * a) * m1 + 1.0f) * (ig * x);
                    __builtin_amdgcn_sched_barrier(0);
                }
        }
#define SCAN_STEP(SH) \
        "v_fmac_f32_dpp %0, %0, %4 " SH " row_mask:0xf bank_mask:0xf\n\tv_fmac_f32_dpp %1, %1, %5 " SH " row_mask:0xf bank_mask:0xf\n\t" \
        "v_fmac_f32_dpp %2, %2, %6 " SH " row_mask:0xf bank_mask:0xf\n\tv_fmac_f32_dpp %3, %3, %7 " SH " row_mask:0xf bank_mask:0xf\n\t" \
        "v_mul_f32_dpp %4, %4, %4 " SH " row_mask:0xf bank_mask:0xf\n\tv_mul_f32_dpp %5, %5, %5 " SH " row_mask:0xf bank_mask:0xf\n\t" \
        "v_mul_f32_dpp %6, %6, %6 " SH " row_mask:0xf bank_mask:0xf\n\tv_mul_f32_dpp %7, %7, %7 " SH " row_mask:0xf bank_mask:0xf\n\t"
#define SCAN_CARRY(BC) \
        "v_fmac_f32_dpp %0, %8, %4 " BC " row_mask:0xf bank_mask:0xf\n\tv_fmac_f32_dpp %1, %9, %5 " BC " row_mask:0xf bank_mask:0xf\n\t" \
        "v_fmac_f32_dpp %2, %10, %6 " BC " row_mask:0xf bank_mask:0xf\n\tv_fmac_f32_dpp %3, %11, %7 " BC " row_mask:0xf bank_mask:0xf\n\t" \
        "v_mul_f32_dpp %4, %12, %4 " BC " row_mask:0xf bank_mask:0xf\n\tv_mul_f32_dpp %5, %13, %5 " BC " row_mask:0xf bank_mask:0xf\n\t" \
        "v_mul_f32_dpp %6, %14, %6 " BC " row_mask:0xf bank_mask:0xf\n\tv_mul_f32_dpp %7, %15, %7 " BC " row_mask:0xf bank_mask:0xf\n\t"
#define SCAN_OUT(A, L) "+v"(L[0]), "+v"(L[1]), "+v"(L[2]), "+v"(L[3]), "+v"(A[0]), "+v"(A[1]), "+v"(A[2]), "+v"(A[3])
#define SCAN_IN(A, L) "v"(L[0]), "v"(L[1]), "v"(L[2]), "v"(L[3]), "v"(A[0]), "v"(A[1]), "v"(A[2]), "v"(A[3])
#pragma unroll
        for (int ai = 0; ai < 2; ++ai) {
            asm volatile("s_nop 1\n\t" SCAN_STEP("row_shr:1") SCAN_STEP("row_shr:2") SCAN_STEP("row_shr:4") SCAN_STEP("row_shr:8") "s_nop 1" : SCAN_OUT(acc[ai][0][0][0], acc[ai][0][0][1]));
#pragma unroll
            for (int m = 1; m < 4; ++m)
                asm volatile("s_nop 1\n\t" SCAN_STEP("row_shr:1") SCAN_STEP("row_shr:2") SCAN_STEP("row_shr:4") SCAN_STEP("row_shr:8") SCAN_CARRY("row_newbcast:15") "s_nop 1"
                             : SCAN_OUT(acc[ai][0][m][0], acc[ai][0][m][1]) : SCAN_IN(acc[ai][0][m - 1][0], acc[ai][0][m - 1][1]));
            asm volatile("s_nop 1\n\t" SCAN_STEP("row_shl:1") SCAN_STEP("row_shl:2") SCAN_STEP("row_shl:4") SCAN_STEP("row_shl:8") "s_nop 1" : SCAN_OUT(acc[ai][1][3][0], acc[ai][1][3][1]));
#pragma unroll
            for (int m = 2; m >= 0; --m)
                asm volatile("s_nop 1\n\t" SCAN_STEP("row_shl:1") SCAN_STEP("row_shl:2") SCAN_STEP("row_shl:4") SCAN_STEP("row_shl:8") SCAN_CARRY("row_newbcast:0") "s_nop 1"
                             : SCAN_OUT(acc[ai][1][m][0], acc[ai][1][m][1]) : SCAN_IN(acc[ai][1][m + 1][0], acc[ai][1][m + 1][1]));
            const int seg = 2 * ai + wr;
            if (fr == 15) {
#pragma unroll
                for (int j = 0; j < 4; ++j) *(LAS f32x2*)(scr + ((seg * 2 + 0) * 64 + cl + j) * 2) = (f32x2){acc[ai][0][3][0][j], acc[ai][0][3][1][j]};
            }
            if (fr == 0) {
#pragma unroll
                for (int j = 0; j < 4; ++j) *(LAS f32x2*)(scr + ((seg * 2 + 1) * 64 + cl + j) * 2) = (f32x2){acc[ai][1][0][0][j], acc[ai][1][0][1][j]};
            }
        }
#undef SCAN_STEP
#undef SCAN_CARRY
#undef SCAN_OUT
#undef SCAN_IN
        u32x2 zw[2][4];
        {
#pragma unroll
            for (int ai = 0; ai < 2; ++ai)
#pragma unroll
                for (int m = 0; m < 4; ++m) zw[ai][m] = *(const u32x2*)(SZB + (size_t)(row0 + ai * 128 + m * 16) * 1024 + ch0);
        }
        WG_BAR();
        {
            const int t = tq;
            LAS float* car = scr + 1024;
            if (t < 128) { const int d = t >> 6, c = t & 63;
                float h = cin;
#pragma unroll
                for (int s = 0; s < 4; ++s) { const int seg = d ? 3 - s : s; car[(seg * 2 + d) * 64 + c] = h; const f32x2 tb = *(const LAS f32x2*)(scr + ((seg * 2 + d) * 64 + c) * 2); h = tb.x * h + tb.y; }
                gr_store(gran + (d == 0 ? 2 * GR_N : 0) + (size_t)((pm - 64) * 8 + (pn >> 1)) * 128 + 64 * (pn & 1) + c, epochF + (unsigned)d, h);
            }
            {
                WG_BAR();
#pragma unroll
                for (int ai = 0; ai < 2; ++ai) {
                    const int seg = 2 * ai + wr;
                    const f32x4 hf = *(const LAS f32x4*)(car + (seg * 2 + 0) * 64 + cl), hb = *(const LAS f32x4*)(car + (seg * 2 + 1) * 64 + cl);
#pragma unroll
                    for (int m = 0; m < 4; ++m) {
                        const size_t r = row0 + ai * 128 + m * 16;
                        const f32x4 z = unpack4(zw[ai][m]);
                        const f32x4 y = (acc[ai][0][m][0] * hf + acc[ai][0][m][1]) + (acc[ai][1][m][0] * hb + acc[ai][1][m][1]);
                        *(u32x2*)(BIG + r * 2048 + 1024 + ch0) = pack4(y * z);
                    }
                }
            }
        }
        WG_BAR();
        return false;
    }
};

struct EpiG2 {
    const bf16_t* RAT; const bf16_t* SMB; bf16_t* MG; unsigned* cnt; unsigned* pcnt;
    __device__ __forceinline__ bool operator()(Acc& acc, const Unit& u, int wr, int wc, int fr, int fq) const {
        const unsigned row0 = (unsigned)u.pm * 256 + wr * 64 + fr; const unsigned col0 = 256 * u.pn + 32 * wc + 8 * fq;
        const bf16_t* src = u.kk == 0 ? RAT : SMB;
#pragma unroll
        for (int ai = 0; ai < 2; ++ai)
#pragma unroll
            for (int m = 0; m < 4; ++m) {
                if (m == 2) asm volatile("" ::: "memory");
#pragma unroll
                for (int bj = 0; bj < 2; ++bj) {
                    const unsigned off = (row0 + ai * 128 + m * 16) * 1024u + col0 + 128 * bj;
                    const u32x4 w = *(const u32x4*)(src + off);
                    acc[ai][bj][m][0] = acc[ai][bj][m][0] * unpack4((u32x2){w.x, w.y});
                    acc[ai][bj][m][1] = acc[ai][bj][m][1] * unpack4((u32x2){w.z, w.w});
                    if (u.kk == 1) { const u32x2 a = pack4(acc[ai][bj][m][0]), b = pack4(acc[ai][bj][m][1]); *(u32x4*)(MG + off) = (u32x4){a.x, a.y, b.x, b.y}; }
                }
            }
        unsigned* const pc = u.pm >= 64 ? cnt : (pcnt != nullptr ? pcnt + u.pm * 16 : nullptr);
        if (pc != nullptr && u.kk == 1) {
            asm volatile("s_waitcnt vmcnt(0)" ::: "memory"); WG_BAR();
            if (wr == 0 && wc == 0 && fq == 0 && fr == 0) { __builtin_amdgcn_fence(__ATOMIC_RELEASE, "agent"); asm volatile("s_waitcnt vmcnt(0)" ::: "memory");
                __hip_atomic_fetch_add(pc, 1u, __ATOMIC_RELAXED, __HIP_MEMORY_SCOPE_AGENT); }
        }
        return u.kk == 0;
    }
};

template <bool FINAL> struct EpiG3 {
    static constexpr bool AFTER_DRAIN = true;
    const float* xin_lat; const float* xin_ctx; float* out_lat; float* out_ctx; const float* mod;
    const float* gn; const float* modn;
    bf16_t* BIG; u64* xg; unsigned* tmo; unsigned epoch;
    LAS float* scr;
    unsigned* cnt;
    __device__ __forceinline__ void final(Acc& acc, const Unit& u, int wr, int wc, int lane, LAS unsigned char* lds) const {
        const int pm = u.pm; const bool isctx = pm >= 64; const int v = isctx ? 2 : (pm >> 5);
        const float* xin = isctx ? xin_ctx : xin_lat; float* out = isctx ? out_ctx : out_lat;
        const int fr = lane & 15, fq = lane >> 4, wave = wr * 4 + wc;
        const unsigned col = 256 * u.pn + 4 * lane;
        const unsigned rbase = (unsigned)(isctx ? pm - 64 : pm) * 256 + 16 * wave;
        const f32x4 gt = *(const f32x4*)(mod + v * 3072 + 2048 + col);
        f32x4 y[2][16]; float tot = 0.f;
#pragma unroll
        for (int h = 0; h < 2; ++h) {
#pragma unroll
            for (int bj = 0; bj < 2; ++bj)
#pragma unroll
                for (int m = 0; m < 4; ++m)
#pragma unroll
                    for (int n = 0; n < 2; ++n) { const int rowh = 64 * wr + 16 * m + fr, c16 = 32 * bj + 8 * wc + 4 * n + fq;
                        *(LAS f32x4*)(lds + rowh * 1024 + ((c16 ^ (rowh & 7)) << 4)) = acc[h][bj][m][n]; }
            WG_BAR();
#pragma unroll
            for (int rb = 0; rb < 4; ++rb) {
            f32x4 xv[4];
#pragma unroll
            for (int r8 = 0; r8 < 4; ++r8) { const float* rowp = xin + (size_t)(rbase + 128 * h + 4 * rb + r8) * 1024; xv[r8] = *(const f32x4*)(rowp + col); }
#pragma unroll
            for (int r8 = 0; r8 < 4; ++r8) { const int rr = 4 * rb + r8, rowh = 16 * wave + rr;
                const f32x4 a4 = *(const LAS f32x4*)(lds + rowh * 1024 + ((lane ^ (rowh & 7)) << 4));
                const f32x4 yy = xv[r8] + gt * a4; y[h][rr] = yy;
                if constexpr (!FINAL) { bf16_t* rowo = (bf16_t*)out + (size_t)(rbase + 128 * h + rr) * 2048; *(u32x2*)(rowo + col) = pack4(yy); }
                float ss = (yy[0] * yy[0] + yy[1] * yy[1]) + (yy[2] * yy[2] + yy[3] * yy[3]);
                ss += dppf<DPP_SHR(1)>(0.f, ss); ss += dppf<DPP_SHR(2)>(0.f, ss); ss += dppf<DPP_SHR(4)>(0.f, ss); ss += dppf<DPP_SHR(8)>(0.f, ss);
                const float rsum = (__builtin_bit_cast(float, __builtin_amdgcn_readlane(__builtin_bit_cast(int, ss), 15)) + __builtin_bit_cast(float, __builtin_amdgcn_readlane(__builtin_bit_cast(int, ss), 31)))
                                 + (__builtin_bit_cast(float, __builtin_amdgcn_readlane(__builtin_bit_cast(int, ss), 47)) + __builtin_bit_cast(float, __builtin_amdgcn_readlane(__builtin_bit_cast(int, ss), 63)));
                if (lane == 16 * h + rr) tot = rsum;
                if (r8 & 1) __builtin_amdgcn_sched_barrier(0); }
            asm volatile("" ::: "memory");
            }
            WG_BAR();
        }
        float rstd = 0.f;
        if (lane < 32) {
            const unsigned row = 128 * (lane >> 4) + 16 * wave + (lane & 15);
            u64* g = xg + ((size_t)pm * 256 + row) * 4;
            gr_store(g + u.pn, epoch, tot);
            u64 w[4]; unsigned spins = 0;
            for (;;) {
                bool ok = true;
#pragma unroll
                for (int t = 0; t < 4; ++t) { w[t] = gr_load(g + t); ok = ok && ((unsigned)(w[t] >> 32) == epoch); }
                if (ok) break;
                __builtin_amdgcn_s_sleep(2);
                if ((++spins & 63u) == 0u) { if (__hip_atomic_load(tmo, __ATOMIC_RELAXED, __HIP_MEMORY_SCOPE_AGENT) != 0u) break; if (spins > (1u << 16)) { __hip_atomic_store(tmo, 1u, __ATOMIC_RELAXED, __HIP_MEMORY_SCOPE_AGENT); break; } }
            }
            const float t4 = (__uint_as_float((unsigned)w[0]) + __uint_as_float((unsigned)w[1])) + (__uint_as_float((unsigned)w[2]) + __uint_as_float((unsigned)w[3]));
            rstd = rsqrtf(t4 * (1.0f / 1024.0f) + RMS_EPS);
        }
        f32x4 gs = *(const f32x4*)(gn + col), sh = (f32x4){0.f, 0.f, 0.f, 0.f};
        if constexpr (!FINAL) { gs = gs * (*(const f32x4*)(modn + v * 3072 + 1024 + col) + 1.0f); sh = *(const f32x4*)(modn + v * 3072 + col); }
        const unsigned hbase = (unsigned)pm * 256 + 16 * wave;
#pragma unroll
        for (int h = 0; h < 2; ++h)
#pragma unroll
            for (int rr = 0; rr < 16; ++rr) {
                const float rs = __builtin_bit_cast(float, __builtin_amdgcn_readlane(__builtin_bit_cast(int, rstd), 16 * h + rr));
                if constexpr (FINAL) { float* rowo = out + (size_t)(rbase + 128 * h + rr) * 1024; *(f32x4*)(rowo + col) = y[h][rr] * rs * gs; }
                else { bf16_t* rowh_ = BIG + (size_t)(hbase + 128 * h + rr) * 2048 + 1024; *(u32x2*)(rowh_ + col) = pack4(y[h][rr] * rs * gs + sh); }
            }
        if (cnt != nullptr && isctx) {
            asm volatile("s_waitcnt vmcnt(0)" ::: "memory"); WG_BAR();
            if (wave == 0 && lane == 0) { __builtin_amdgcn_fence(__ATOMIC_RELEASE, "agent"); asm volatile("s_waitcnt vmcnt(0)" ::: "memory");
                __hip_atomic_fetch_add(cnt, 1u, __ATOMIC_RELAXED, __HIP_MEMORY_SCOPE_AGENT); }
        }
    }
};

template <bool FINAL> struct EpiG3old {
    const float* xin_lat; const float* xin_ctx; float* out_lat; float* out_ctx; const float* mod;
    const float* gn; const float* modn;
    bf16_t* BIG; u64* xg; unsigned* tmo; unsigned epoch;
    LAS float* scr;
    unsigned* cnt;
    __device__ __forceinline__ bool operator()(Acc& acc, const Unit& u, int wr, int wc, int fr, int fq) const {
        const int pm = u.pm; const bool isctx = pm >= 64; const int v = isctx ? 2 : (pm >> 5);
        const float* xin = isctx ? xin_ctx : xin_lat; float* out = isctx ? out_ctx : out_lat;
        const size_t row0 = (size_t)(isctx ? pm - 64 : pm) * 256 + wr * 64 + fr; const int col0 = 256 * u.pn + 32 * wc + 4 * fq;
        const int tq = (wr * 4 + wc) * 64 + fq * 16 + fr, lane = fq * 16 + fr;
        {
            f32x4 gt[2][2];
#pragma unroll
            for (int bj = 0; bj < 2; ++bj)
#pragma unroll
                for (int n = 0; n < 2; ++n) gt[bj][n] = *(const f32x4*)(mod + v * 3072 + 2048 + col0 + 128 * bj + 16 * n);
#pragma unroll
            for (int ai = 0; ai < 2; ++ai)
#pragma unroll
                for (int m = 0; m < 4; ++m) {
                    float ss = 0.f;
#pragma unroll
                    for (int bj = 0; bj < 2; ++bj)
#pragma unroll
                        for (int n = 0; n < 2; ++n) { const size_t off = (row0 + ai * 128 + m * 16) * 1024 + col0 + 128 * bj + 16 * n;
                            f32x4 xr; if constexpr (FINAL) xr = unpack4(*(const u32x2*)((const bf16_t*)xin + off + (row0 + ai * 128 + m * 16) * 1024)); else xr = *(const f32x4*)(xin + off);
                            const f32x4 y = xr + gt[bj][n] * acc[ai][bj][m][n]; acc[ai][bj][m][n] = y;
                            if constexpr (!FINAL) *(f32x4*)(out + off) = y;
                            ss += (y[0] * y[0] + y[1] * y[1]) + (y[2] * y[2] + y[3] * y[3]); }
                    ss += __builtin_bit_cast(float, __builtin_amdgcn_ds_bpermute((lane ^ 16) << 2, __builtin_bit_cast(int, ss)));
                    ss += __builtin_bit_cast(float, __builtin_amdgcn_ds_bpermute((lane ^ 32) << 2, __builtin_bit_cast(int, ss)));
                    if (fq == 0) scr[(ai * 128 + wr * 64 + m * 16 + fr) * 4 + wc] = ss;
                    if (m & 1) asm volatile("" ::: "memory");
                }
        }
        WG_BAR();
        if (tq < 256) {
            const f32x4 p = *(const LAS f32x4*)(scr + tq * 4);
            u64* g = xg + ((size_t)pm * 256 + tq) * 4;
            gr_store(g + u.pn, epoch, (p[0] + p[1]) + (p[2] + p[3]));
            u64 w[4]; unsigned spins = 0;
            for (;;) {
                bool ok = true;
#pragma unroll
                for (int t = 0; t < 4; ++t) { w[t] = gr_load(g + t); ok = ok && ((unsigned)(w[t] >> 32) == epoch); }
                if (ok) break;
                __builtin_amdgcn_s_sleep(2);
                if ((++spins & 63u) == 0u) { if (__hip_atomic_load(tmo, __ATOMIC_RELAXED, __HIP_MEMORY_SCOPE_AGENT) != 0u) break; if (spins > (1u << 16)) { __hip_atomic_store(tmo, 1u, __ATOMIC_RELAXED, __HIP_MEMORY_SCOPE_AGENT); break; } }
            }
            const float tot = (__uint_as_float((unsigned)w[0]) + __uint_as_float((unsigned)w[1])) + (__uint_as_float((unsigned)w[2]) + __uint_as_float((unsigned)w[3]));
            scr[1024 + tq] = rsqrtf(tot * (1.0f / 1024.0f) + RMS_EPS);
        }
        WG_BAR();
        {
            f32x4 gs[2][2], sh[2][2];
#pragma unroll
            for (int bj = 0; bj < 2; ++bj)
#pragma unroll
                for (int n = 0; n < 2; ++n) { const int c = col0 + 128 * bj + 16 * n; gs[bj][n] = *(const f32x4*)(gn + c);
                    if constexpr (!FINAL) { gs[bj][n] = gs[bj][n] * (*(const f32x4*)(modn + v * 3072 + 1024 + c) + 1.0f); sh[bj][n] = *(const f32x4*)(modn + v * 3072 + c); } }
            const size_t hrow0 = (size_t)pm * 256 + wr * 64 + fr;
#pragma unroll
            for (int ai = 0; ai < 2; ++ai)
#pragma unroll
                for (int m = 0; m < 4; ++m) {
                    const float rstd = scr[1024 + ai * 128 + wr * 64 + m * 16 + fr];
#pragma unroll
                    for (int bj = 0; bj < 2; ++bj)
#pragma unroll
                        for (int n = 0; n < 2; ++n) { const int c = col0 + 128 * bj + 16 * n;
                            if constexpr (FINAL) *(f32x4*)(out + (row0 + ai * 128 + m * 16) * 1024 + c) = acc[ai][bj][m][n] * rstd * gs[bj][n];
                            else *(u32x2*)(BIG + (hrow0 + ai * 128 + m * 16) * 2048 + 1024 + c) = pack4(acc[ai][bj][m][n] * rstd * gs[bj][n] + sh[bj][n]); }
                }
        }
        if (cnt != nullptr && isctx) asm volatile("s_waitcnt vmcnt(0)" ::: "memory");
        WG_BAR();
        if (cnt != nullptr && isctx && tq == 0) { __builtin_amdgcn_fence(__ATOMIC_RELEASE, "agent"); asm volatile("s_waitcnt vmcnt(0)" ::: "memory");
            __hip_atomic_fetch_add(cnt, 1u, __ATOMIC_RELAXED, __HIP_MEMORY_SCOPE_AGENT); }
        return false;
    }
};

#define XB_TMO      128
#define XB_XCNT(j)  (256  + 64 * (j))
#define XB_XSUB(j)  (1280 + 64 * (j))
#define XB_XGEN(j)  (2304 + 64 * (j))
#define XB_TOP      3328
#define XB_TOPGEN   3392
#define XCD_BAR_WORDS 3456
#define XB_SPIN_CAP (1u << 18)
__device__ __forceinline__ unsigned xb_ld(unsigned* p)              { return __hip_atomic_load(p, __ATOMIC_RELAXED, __HIP_MEMORY_SCOPE_AGENT); }
__device__ __forceinline__ unsigned xb_add(unsigned* p, unsigned v) { return __hip_atomic_fetch_add(p, v, __ATOMIC_RELAXED, __HIP_MEMORY_SCOPE_AGENT); }
__device__ __forceinline__ unsigned xb_xcc_id() { return (unsigned)__builtin_amdgcn_s_getreg((3 << 11) | 20) & 0xFu; }
#define XB_SPIN(cond, bar) do { unsigned _sp = 0; while (cond) { __builtin_amdgcn_s_sleep(1); \
    if ((++_sp & 255u) == 0u) { if (xb_ld(&(bar)[XB_TMO])) break; if (_sp > XB_SPIN_CAP) { atomicAdd(&(bar)[XB_TMO], 1u); break; } } } } while (0)
struct XcdBarrier { unsigned* bar; unsigned x; volatile LAS unsigned* st; };
__device__ __forceinline__ XcdBarrier xcd_barrier_post(unsigned* bar, volatile LAS unsigned* st) {
    XcdBarrier b; b.bar = bar; b.x = xb_xcc_id(); b.st = st;
    if (threadIdx.x == 0) (void)xb_add(&bar[XB_XCNT(b.x)], 1u);
    return b;
}
__device__ __forceinline__ void xcd_barrier_complete(unsigned* bar, unsigned x, unsigned& nloc, unsigned& nx) {
    const unsigned G = gridDim.x * gridDim.y * gridDim.z;
    unsigned sum, cnt, mine, sp = 0u;
    for (;;) {
        sum = 0u; cnt = 0u; mine = 0u;
#pragma unroll
        for (unsigned j = 0; j < 16; ++j) { const unsigned c = xb_ld(&bar[XB_XCNT(j)]); sum += c; cnt += (c > 0u) ? 1u : 0u; mine = (j == x) ? c : mine; }
        if (sum == G) break;
        __builtin_amdgcn_s_sleep(1);
        if ((++sp & 255u) == 0u) { if (xb_ld(&bar[XB_TMO])) break; if (sp > XB_SPIN_CAP) { atomicAdd(&bar[XB_TMO], 1u); break; } }
    }
    nloc = mine > 0u ? mine : 1u; nx = cnt > 0u ? cnt : 1u;
}
__device__ __forceinline__ void xcd_barrier(const XcdBarrier& b, bool leader) {
    asm volatile("s_waitcnt vmcnt(0)" ::: "memory");
    __syncthreads();
    if (leader) {
        unsigned* bar = b.bar;
        __builtin_amdgcn_s_waitcnt(0);
        unsigned nloc = b.st[0], nx = b.st[1];
        if (nloc == 0u) { xcd_barrier_complete(bar, b.x, nloc, nx); b.st[0] = nloc; b.st[1] = nx; }
        const unsigned old = xb_add(&bar[XB_XSUB(b.x)], 1u);
        const unsigned gen = old / nloc;
        if (old + 1u == (gen + 1u) * nloc) {
            __builtin_amdgcn_fence(__ATOMIC_RELEASE, "agent");
            asm volatile("s_waitcnt vmcnt(0)" ::: "memory");
            const unsigned og = xb_add(&bar[XB_TOP], 1u);
            const unsigned tg = og / nx;
            if (og + 1u == (tg + 1u) * nx) xb_add(&bar[XB_TOPGEN], 1u);
            else XB_SPIN(xb_ld(&bar[XB_TOPGEN]) == tg, bar);
            __builtin_amdgcn_fence(__ATOMIC_ACQUIRE, "agent");
            xb_add(&bar[XB_XGEN(b.x)], 1u);
            asm volatile("s_waitcnt vmcnt(0)" ::: "memory");
        } else {
            XB_SPIN(xb_ld(&bar[XB_XGEN(b.x)]) == gen, bar);
            __builtin_amdgcn_fence(__ATOMIC_ACQUIRE, "agent");
            asm volatile("s_waitcnt vmcnt(0)" ::: "memory");
        }
    }
    __syncthreads();
}

struct Args { const float* in[20]; float* out; unsigned char* ws; int ph_lo, ph_hi; };
typedef __attribute__((address_space(4))) const Args CArgs;
struct InTab { CArgs* ka; __device__ __forceinline__ const float* operator[](int i) const { return ka->in[i]; } };
struct Frame {
    LAS unsigned char* lds; int tid, lane, wave, vcu, G, bx;
    InTab in; float* out; unsigned char* ws;
    __device__ __forceinline__ void ids() { const int l = fresh_lane(); lane = l; tid = wave * 64 + l; }
};
__device__ __forceinline__ int opaque_v(int x) { asm volatile("" : "+v"(x)); return x; }
__device__ __forceinline__ unsigned opaque_s(unsigned x) { asm volatile("" : "+s"(x)); return x; }
__device__ __forceinline__ float wave_sum(float v, int lane) {
#pragma unroll
    for (int o = 1; o < 64; o <<= 1) v += __builtin_bit_cast(float, __builtin_amdgcn_ds_bpermute((lane ^ o) << 2, __builtin_bit_cast(int, v)));
    return v;
}

__device__ __forceinline__ int w1_dest_row(int s) {
    const int chunk = s >> 10, ch = s & 1023;
    if (chunk < 4) { const int g = chunk == 0 ? 0 : (chunk == 1 ? 2 : (chunk == 2 ? 1 : 3)); return 256 * (ch >> 6) + 128 * (g >> 1) + 32 * ((ch >> 4) & 3) + 16 * (g & 1) + (ch & 15); }
    if (chunk < 6) { const int pn = (chunk == 4 ? 16 : 20) + (ch >> 8), r = ch & 255; return 256 * pn + 128 * (r >> 7) + 32 * ((r >> 5) & 3) + 16 * ((r >> 2) & 1) + 4 * ((r >> 3) & 3) + (r & 3); }
    { const int pn = 24 + (ch >> 7), r = ch & 127; return 256 * pn + 128 * (chunk - 6) + 32 * (r >> 5) + 16 * ((r >> 2) & 1) + 4 * ((r >> 3) & 3) + (r & 3); }
}
__device__ __forceinline__ int perm8_dest_row(int o) { return (o & ~31) | (((o >> 2) & 1) << 4) | (((o >> 3) & 3) << 2) | (o & 3); }
template <int MODE> __device__ __forceinline__ void tr_item(const float* W, int ldsrc, int k0, int n0, bf16_t* dst, int lddst, int dcol0, int p0, LAS float* scr, int lane) {
#pragma unroll 8
    for (int i = 0; i < 32; ++i) { const int kk = 2 * i + (lane >> 5); scr[kk * 33 + (lane & 31)] = W[(size_t)(k0 + kk) * ldsrc + n0 + (lane & 31)]; }
    LDS_WAIT(); asm volatile("" ::: "memory");
    const int c = lane & 7;
#pragma unroll
    for (int j = 0; j < 4; ++j) { const int n = (lane >> 3) + 8 * j; const LAS float* s = scr + (8 * c) * 33 + n;
        u32x4 o; o.x = cvt_pk_bf16(s[0 * 33], s[1 * 33]); o.y = cvt_pk_bf16(s[2 * 33], s[3 * 33]); o.z = cvt_pk_bf16(s[4 * 33], s[5 * 33]); o.w = cvt_pk_bf16(s[6 * 33], s[7 * 33]);
        const int sn = n0 + n; int drow;
        if (MODE == 0) drow = w1_dest_row(sn);
        else if (MODE == 1) drow = perm8_dest_row(sn);
        else if (MODE == 2) drow = sn;
        else if (MODE == 3) drow = p0 + 32 * (sn >> 5) + 16 * ((sn >> 2) & 1) + 4 * ((sn >> 3) & 3) + (sn & 3);
        else drow = p0 + 256 * (sn >> 6) + 32 * ((sn >> 4) & 3) + (sn & 15);
        *(u32x4*)(dst + (size_t)drow * lddst + dcol0 + k0 + 8 * c) = o; }
    LDS_WAIT(); asm volatile("" ::: "memory");
}
__device__ __forceinline__ void convert_layer(Frame& F, int l, int gw, int nw) {
    F.ids();
    LAS float* scr = (LAS float*)(F.lds + F.wave * 16384);
    for (int it = gw; it < 4096 + 1536 + 512; it += nw) {
        if (it < 4096) { const int kb = it >> 8, nb = it & 255;
            tr_item<0>(F.in[7] + (size_t)l * 1024 * 8192, 8192, 64 * kb, 32 * nb, (bf16_t*)(F.ws + WS_W1T) + (size_t)l * 8192 * 1024, 1024, 0, 0, scr, F.lane); }
        else if (it < 4096 + 1536) { int r = it - 4096; const int which = r / 512; r %= 512; const int kb = r >> 5, nb = r & 31;
            if (which == 0) tr_item<1>(F.in[16] + (size_t)l * 1024 * 1024, 1024, 64 * kb, 32 * nb, (bf16_t*)(F.ws + WS_WABT) + (size_t)l * 1024 * 2048, 2048, 0, 0, scr, F.lane);
            else if (which == 1) tr_item<1>(F.in[17] + (size_t)l * 1024 * 1024, 1024, 64 * kb, 32 * nb, (bf16_t*)(F.ws + WS_WABT) + (size_t)l * 1024 * 2048, 2048, 1024, 0, scr, F.lane);
            else tr_item<2>(F.in[18] + (size_t)l * 1024 * 1024, 1024, 64 * kb, 32 * nb, (bf16_t*)(F.ws + WS_WOT) + (size_t)l * 1024 * 1024, 1024, 0, 0, scr, F.lane); }
        else { int r = it - 4096 - 1536; const bool ctxl = r >= 256; if (ctxl) r -= 256; const int mat = r >> 3; r &= 7; const int kb = r >> 2, nb = r & 3; const int dir = (mat >> 4) & 1, isI = (mat >> 3) & 1, blk = mat & 7;
            const float* W = (isI ? F.in[13] : F.in[11]) + (size_t)((l * 2 + dir) * 8 + blk) * 128 * 128;
            if (!ctxl) tr_item<3>(W, 128, 64 * kb, 32 * nb, (bf16_t*)(F.ws + WS_GWT) + (size_t)l * 4096 * 128, 128, 0, (dir * 8 + blk) * 256 + 128 * isI, scr, F.lane);
            else tr_item<4>(W, 128, 64 * kb, 32 * nb, (bf16_t*)(F.ws + WS_GWTC) + (size_t)l * 4096 * 128, 128, 0, 512 * blk + 128 * dir + 16 * isI, scr, F.lane); }
    }
}
__device__ __forceinline__ void p0_prologue(Frame& F) {
    F.ids();
    const float* c = F.in[1]; const float* c_ctx = F.in[3]; const float* w_ada = F.in[4]; const float* b_ada = F.in[5];
    float* MOD = (float*)(F.ws + WS_MOD);
    if (F.bx < 192) {
        LAS float* sc = (LAS float*)F.lds;
        LAS float* red = sc + 3072;
        for (int i = F.tid; i < 3072; i += 512) { const float x = i < 2048 ? c[i] : c_ctx[i - 2048]; sc[i] = x * sigmoidf_(x); }
        __syncthreads();
        for (int u = F.bx; u < 192; u += F.G) {
            const int l = u / 96, cl = F.lane & 31, col = (u % 96) * 32 + cl, k0 = F.wave * 128 + (F.lane >> 5);
            const float* W = w_ada + (size_t)l * 1024 * 3072 + col;
            float a0 = 0.f, a1 = 0.f, a2 = 0.f;
#pragma unroll 16
            for (int kk = 0; kk < 64; ++kk) { const int k = k0 + 2 * kk; const float w = W[(size_t)k * 3072]; a0 += sc[k] * w; a1 += sc[1024 + k] * w; a2 += sc[2048 + k] * w; }
            a0 += __builtin_bit_cast(float, __builtin_amdgcn_ds_bpermute((F.lane ^ 32) << 2, __builtin_bit_cast(int, a0)));
            a1 += __builtin_bit_cast(float, __builtin_amdgcn_ds_bpermute((F.lane ^ 32) << 2, __builtin_bit_cast(int, a1)));
            a2 += __builtin_bit_cast(float, __builtin_amdgcn_ds_bpermute((F.lane ^ 32) << 2, __builtin_bit_cast(int, a2)));
            if (F.lane < 32) { red[(F.wave * 3 + 0) * 32 + cl] = a0; red[(F.wave * 3 + 1) * 32 + cl] = a1; red[(F.wave * 3 + 2) * 32 + cl] = a2; }
            __syncthreads();
            if (F.tid < 96) { const int v = F.tid >> 5, c2 = F.tid & 31; float s = 0.f;
#pragma unroll
                for (int w = 0; w < 8; ++w) s += red[(w * 3 + v) * 32 + c2];
                const int colo = (u % 96) * 32 + c2; MOD[(l * 3 + v) * 3072 + colo] = s + b_ada[l * 3072 + colo]; }
            __syncthreads();
        }
    }
    __syncthreads();
    { const int gi = F.bx * 512 + F.tid; if (gi < NL * 2 * 1024) { const float e = __builtin_amdgcn_exp2f(-F.in[15][gi] * LOG2E);
            ((float*)(F.ws + WS_CLAM))[gi] = -8.0f * (e * (1.0f + e * (-0.5f + e * (0.33333334f + e * (-0.25f + e * 0.2f))))); } }
    convert_layer(F, 0, F.vcu * NWAVES + F.wave, F.G * NWAVES);
}

__device__ __forceinline__ void norm_phase(Frame& F, int l, bool final) {
    F.ids();
    const int gw = F.vcu * NWAVES + F.wave, NGW = F.G * NWAVES;
    const float* MOD = (const float*)(F.ws + WS_MOD) + (size_t)l * 3 * 3072;
    const float* gsrc = final ? F.in[19] : F.in[6] + l * 1024;
    bf16_t* BIG = (bf16_t*)(F.ws + WS_BIG);
    const int nrows = final ? ML : M;
    f32x4 g4[4];
#pragma unroll
    for (int j = 0; j < 4; ++j) g4[j] = *(const f32x4*)(gsrc + 4 * F.lane + 256 * j);
    for (int row = gw; row < nrows; row += NGW) {
        const bool isctx = row >= ML;
        const float* src = (l == 0 && !final) ? (isctx ? F.in[2] + (size_t)(row - ML) * 1024 : F.in[0] + (size_t)row * 1024)
                                              : (isctx ? (const float*)(F.ws + WS_CTX1) + (size_t)(row - ML) * 1024 : F.out + (size_t)row * 1024);
        f32x4 v[4]; float ss = 0.f;
#pragma unroll
        for (int j = 0; j < 4; ++j) { v[j] = *(const f32x4*)(src + 4 * F.lane + 256 * j); ss += (v[j][0] * v[j][0] + v[j][1] * v[j][1]) + (v[j][2] * v[j][2] + v[j][3] * v[j][3]); }
        const float rstd = rsqrtf(wave_sum(ss, F.lane) * (1.0f / 1024.0f) + RMS_EPS);
        if (final) {
#pragma unroll
            for (int j = 0; j < 4; ++j) *(f32x4*)(F.out + (size_t)row * 1024 + 4 * F.lane + 256 * j) = v[j] * rstd * g4[j];
        } else {
            const int vi = isctx ? 2 : (row >> 13);
            const float* sh = MOD + vi * 3072; const float* scl = sh + 1024;
#pragma unroll
            for (int j = 0; j < 4; ++j) { const int cidx = 4 * F.lane + 256 * j;
                const f32x4 y = v[j] * rstd * g4[j]; const f32x4 h = y * (*(const f32x4*)(scl + cidx) + 1.0f) + *(const f32x4*)(sh + cidx);
                *(u32x2*)(BIG + (size_t)row * 2048 + 1024 + cidx) = pack4(h); }
        }
    }
}

__device__ __forceinline__ void panel_wait(const pg8::Sched& S, unsigned* pc, int wave) {
    asm volatile("" : "+s"(wave));
    if (wave == 0) {
        pg8::Unit u0;
        for (int i = 0; S.next(i, u0); ++i) { unsigned spins = 0;
            while (__hip_atomic_load(pc + u0.pm * 16, __ATOMIC_RELAXED, __HIP_MEMORY_SCOPE_AGENT) < 4u) { __builtin_amdgcn_s_sleep(2); if (++spins > (1u << 20)) break; } }
        __builtin_amdgcn_fence(__ATOMIC_ACQUIRE, "agent"); asm volatile("s_waitcnt vmcnt(0)" ::: "memory");
    }
    __syncthreads();
}

constexpr int N_PHASES = 12;
__global__ void __launch_bounds__(NWAVES * 64, 2) mk_fwd(Args args) {
    extern __shared__ __attribute__((aligned(16))) unsigned char lds[];
    const int wave_id = __builtin_amdgcn_readfirstlane((int)threadIdx.x >> 6);
    volatile LAS unsigned* MISC = (volatile LAS unsigned*)((LAS unsigned char*)lds + MISC_OFF);
    for (int u = threadIdx.x; u < 128; u += NWAVES * 64) MISC[u] = 0u;
    __syncthreads();
    XcdBarrier bar; bar.bar = (unsigned*)(args.ws + WS_CTL) + CW_BAR; bar.x = 0; bar.st = nullptr;
    if (!MK_PER_PHASE) bar = xcd_barrier_post((unsigned*)(args.ws + WS_CTL) + CW_BAR, MISC + 8);

    for (int it = 2 * args.ph_lo; it < 2 * args.ph_hi; ++it) {
        const int ph = it >> 1;
        if (it & 1) {
            const int kind = ph == 0 ? 7 : (ph == 1 ? 0 : 1 + (ph - 2) % 5);
            if (!((DUP_MASK >> kind) & 1) || kind == 5 || kind == 3) continue;
        }
        CArgs* ka = (CArgs*)__builtin_amdgcn_kernarg_segment_ptr(); asm volatile("" : "+s"(ka));
        Frame F;
        F.lds = (LAS unsigned char*)lds;
        F.wave = wave_id; F.lane = 0; F.tid = 0;
        int bx_ = blockIdx.x, G_ = gridDim.x; asm volatile("" : "+s"(bx_), "+s"(G_));
        F.G = G_; F.bx = bx_; F.vcu = (F.G % 8 == 0) ? (bx_ % 8) * (F.G / 8) + bx_ / 8 : bx_;
        F.in.ka = ka; F.out = ka->out; F.ws = ka->ws;
        LAS float* scr = (LAS float*)(F.lds + SCR_OFF);
        bf16_t* BIG = (bf16_t*)(F.ws + WS_BIG); bf16_t* XC = (bf16_t*)(F.ws + WS_XC); bf16_t* SZB = (bf16_t*)(F.ws + WS_SZB); bf16_t* RAT = (bf16_t*)(F.ws + WS_RAT); bf16_t* SMB = (bf16_t*)(F.ws + WS_SMB);
        float* CTX1 = (float*)(F.ws + WS_CTX1);
        if (ph == 0) { p0_prologue(F); }
        else if (ph == 1) { norm_phase(F, 0, false); }
        else {
            const int l = (ph - 2) / 5, sub = 1 + (ph - 2) % 5;
            if (sub == 1) {
                pg8::Gemm g{BIG + 1024, (const bf16_t*)(F.ws + WS_W1T) + (size_t)l * 8192 * 1024, 2048, 1024, 1024, 0, 0, 0, 0, 1};
                unsigned* ctxcnt = (unsigned*)(F.ws + WS_CTL) + CW_CTXCNT + 64 * l;
                if (l == 1 && F.bx < 8) {
                    unsigned* c2 = (unsigned*)(F.ws + WS_CTL) + CW_CG2CNT; unsigned* c3 = (unsigned*)(F.ws + WS_CTL) + CW_CG3CNT;
                    const float* MODp = (const float*)(F.ws + WS_MOD);
                    {   pg8::Gemm ga{BIG, (const bf16_t*)(F.ws + WS_WABT), 2048, 2048, 1024, 1024, 1024, 0, 0};
                        pg8::Sched Sa; Sa.init(0, 4, F.G, F.bx, 2, 8, 64, 0, 4); Sa.list_off = 0;
                        EpiG2 Ea{RAT, SMB, XC, c2, nullptr};
                        pg8::gemm_phase<EpiG2>(F.lds, ga, Sa, Ea, F.wave); }
                    if (F.wave == 0) { unsigned spins = 0; while (__hip_atomic_load(c2, __ATOMIC_RELAXED, __HIP_MEMORY_SCOPE_AGENT) < 8u) { __builtin_amdgcn_s_sleep(4); if (++spins > (1u << 20)) break; }
                        __builtin_amdgcn_fence(__ATOMIC_ACQUIRE, "agent"); asm volatile("s_waitcnt vmcnt(0)" ::: "memory"); }
                    __syncthreads();
                    {   pg8::Gemm gb{XC, (const bf16_t*)(F.ws + WS_WOT), 1024, 1024, 1024, 0, 0, 0, 0};
                        pg8::Sched Sb; Sb.init(0, 4, F.G, F.bx, 1, 8, 64, 0, 4); Sb.list_off = 0;
                        EpiG3old<false> Eb{F.in[0], F.in[2], F.out, CTX1, MODp, F.in[6] + 1024, MODp + 3 * 3072, BIG, (u64*)(F.ws + WS_GRAN) + 3 * GR_N, (unsigned*)(F.ws + WS_CTL) + CW_PTMO, opaque_s(1u), scr, c3};
                        pg8::gemm_phase<EpiG3old<false>>(F.lds, gb, Sb, Eb, F.wave); }
                    if (F.wave == 0) { unsigned spins = 0; while (__hip_atomic_load(c3, __ATOMIC_RELAXED, __HIP_MEMORY_SCOPE_AGENT) < 8u) { __builtin_amdgcn_s_sleep(4); if (++spins > (1u << 20)) break; }
                        __builtin_amdgcn_fence(__ATOMIC_ACQUIRE, "agent"); asm volatile("s_waitcnt vmcnt(0)" ::: "memory"); }
                    __syncthreads();
                }
                {
                    pg8::Sched S; if (l == 0) { S.init(64, 32, F.G, F.bx, 1, 64, 64, 0, 32); S.extra_first = 1; } else { S.init(64, 32, F.G, F.bx); S.late_n = 8; S.late_r = 7; }
                    EpiG1 E{BIG, XC, SZB, RAT, SMB, F.in[8] + l * 3 * 1024, F.in[9] + l * 4 * 1024, F.in[10] + l * 1024, scr, ctxcnt};
                    pg8::gemm_phase<EpiG1>(F.lds, g, S, E, F.wave);
                }
                {
                    pg8::Sched S2; S2.init(0, 1, F.G, F.bx, 1, 32, 64, 0, 16); S2.list_off = 64 % F.G;
                    pg8::Unit u0;
                    if (S2.next(0, u0) || S2.next(1, u0)) {
                        if (F.wave == 0) {
                            const unsigned want = l == 0 ? 64u : 8u; unsigned spins = 0;
                            while (__hip_atomic_load(ctxcnt, __ATOMIC_RELAXED, __HIP_MEMORY_SCOPE_AGENT) < want) { __builtin_amdgcn_s_sleep(4); if (++spins > (1u << 20)) break; }
                            __builtin_amdgcn_fence(__ATOMIC_ACQUIRE, "agent"); asm volatile("s_waitcnt vmcnt(0)" ::: "memory");
                        }
                        __syncthreads();
                        pg8::Gemm g2{XC, (const bf16_t*)(F.ws + WS_GWTC) + (size_t)l * 4096 * 128, 1024, 128, 128, 0, 0, 1, 128};
                        EpiC E2{XC, SZB, BIG, F.in[12] + l * 2048, F.in[14] + l * 2048, (const float*)(F.ws + WS_CLAM) + l * 2048, (u64*)(F.ws + WS_GRAN), (unsigned)(l * 2 + 1), scr};
                        pg8::gemm_phase<EpiC>(F.lds, g2, S2, E2, F.wave);
                    }
                }
                if (l == 0) {
                    const int first = F.G > 96 ? 96 : 0;
                    if (F.bx >= first) { __syncthreads(); convert_layer(F, 1, (F.bx - first) * NWAVES + F.wave, (F.G - first) * NWAVES); }
                }
            } else if (sub == 2 || sub == 3) {
                const int dir = sub - 2;
                pg8::Gemm g{XC, (const bf16_t*)(F.ws + WS_GWT) + (size_t)l * 4096 * 128 + (size_t)dir * 2048 * 128, 1024, 128, 128, 0, 0, 0, 128};
                pg8::Sched S; S.init_pass(F.G, F.bx, dir);
                unsigned* tmo = (unsigned*)(F.ws + WS_CTL) + CW_PTMO;
                if (dir == 0) { EpiP<0> E{XC, SZB, BIG, F.in[12] + l * 2048, F.in[14] + l * 2048, (const float*)(F.ws + WS_CLAM) + l * 2048, (u64*)(F.ws + WS_GRAN), tmo, (unsigned)(l * 2 + 1), scr, F.lds};
                    pg8::pass_phase<EpiP<0>>(F.lds, g, S, E, F.wave); }
                else { EpiP<1> E{XC, SZB, BIG, F.in[12] + l * 2048 + 1024, F.in[14] + l * 2048 + 1024, (const float*)(F.ws + WS_CLAM) + l * 2048 + 1024, (u64*)(F.ws + WS_GRAN), tmo, (unsigned)(l * 2 + 2), scr, F.lds};
                    pg8::pass_phase<EpiP<1>>(F.lds, g, S, E, F.wave); }
            }
            else if (sub == 4) {
                pg8::Gemm g{BIG, (const bf16_t*)(F.ws + WS_WABT) + (size_t)l * 1024 * 2048, 2048, 2048, 1024, 1024, 1024, 0, 0};
                pg8::Sched S; S.init(64, 4, F.G, F.bx, 2); S.wgm = WGM_G23;
                EpiG2 E{RAT, SMB, XC, nullptr, (unsigned*)(F.ws + WS_CTL) + CW_PANCNT + l * 1024};
                pg8::gemm_phase<EpiG2>(F.lds, g, S, E, F.wave);
            } else {
                pg8::Gemm g{XC, (const bf16_t*)(F.ws + WS_WOT) + (size_t)l * 1024 * 1024, 1024, 1024, 1024, 0, 0, 0, 0};
                unsigned* tmo = (unsigned*)(F.ws + WS_CTL) + CW_PTMO; u64* xg = (u64*)(F.ws + WS_GRAN) + 3 * GR_N;
                const float* MODp = (const float*)(F.ws + WS_MOD);
                if (l == 0) {
                    EpiG3<false> E{F.in[0], F.in[2], F.out, CTX1, MODp, F.in[6] + 1024, MODp + 3 * 3072, BIG, xg, tmo, opaque_s(1u), scr, nullptr};
                    pg8::Sched S; S.init(64, 4, F.G, F.bx); S.wgm = WGM_G23;
                    panel_wait(S, (unsigned*)(F.ws + WS_CTL) + CW_PANCNT + l * 1024, F.wave);
                    pg8::gemm_phase<EpiG3<false>>(F.lds, g, S, E, F.wave);
                } else {
                    EpiG3old<true> E{F.out, CTX1, F.out, CTX1, MODp + 3 * 3072, F.in[19], MODp, BIG, xg, tmo, opaque_s(2u), scr, nullptr};
                    pg8::Sched S; S.init(64, 4, F.G, F.bx); S.wgm = WGM_G23;
                    panel_wait(S, (unsigned*)(F.ws + WS_CTL) + CW_PANCNT + l * 1024, F.wave);
                    pg8::gemm_phase<EpiG3old<true>>(F.lds, g, S, E, F.wave);
                }
            }
        }
        if (it < 2 * args.ph_hi - 2 && !(ph >= 2 && (ph - 2) % 5 == 3 && !MK_PER_PHASE)) { const int ln2 = fresh_lane(); xcd_barrier(bar, wave_id == 0 && ln2 == 0); }
#if EXTRA_BARS
        if (ph == 4) { for (int eb = 0; eb < EXTRA_BARS; ++eb) { const int ln3 = fresh_lane(); xcd_barrier(bar, wave_id == 0 && ln3 == 0); } }
#endif
    }
}

extern "C" void kernel_launch(void* const* d_in, const int* in_sizes, int n_in, void* d_out, int out_size, void* d_ws, size_t ws_size, hipStream_t stream) {
    static int grid = 0;
    if (grid == 0) {
        if (n_in != 20 || in_sizes[0] != ML * D || out_size != ML * D || ws_size < WS_END) {
            fprintf(stderr, "kernel_launch: unexpected shapes: n_in %d in0 %d out %d ws %zu (need %zu)\n", n_in, n_in > 0 ? in_sizes[0] : -1, out_size, ws_size, (size_t)WS_END); grid = -1; return; }
        int dev = 0, cus = 0, per_cu = 0;
        if (hipGetDevice(&dev) != hipSuccess || hipDeviceGetAttribute(&cus, hipDeviceAttributeMultiprocessorCount, dev) != hipSuccess) { grid = -1; return; }
        if (hipFuncSetAttribute((const void*)mk_fwd, hipFuncAttributeMaxDynamicSharedMemorySize, LDS_BYTES) != hipSuccess) { fprintf(stderr, "kernel_launch: hipFuncSetAttribute failed\n"); grid = -1; return; }
        if (hipOccupancyMaxActiveBlocksPerMultiprocessor(&per_cu, (const void*)mk_fwd, NWAVES * 64, LDS_BYTES) != hipSuccess || per_cu < 1) {
            fprintf(stderr, "kernel_launch: occupancy query reports %d workgroups per CU\n", per_cu); (void)hipGetLastError(); grid = -1; return; }
        grid = cus < 256 ? cus : 256;
    }
    if (grid < 0) return;
    if (hipMemsetAsync((char*)d_ws + WS_CTL, 0, CTL_ZERO_BYTES, stream) != hipSuccess) return;
    Args a{};
    for (int i = 0; i < 20; ++i) a.in[i] = (const float*)d_in[i];
    a.out = (float*)d_out; a.ws = (unsigned char*)d_ws;
#if MK_PER_PHASE
    for (int ph = 0; ph < N_PHASES; ++ph) { a.ph_lo = ph; a.ph_hi = ph + 1; hipLaunchKernelGGL(mk_fwd, dim3(grid), dim3(NWAVES * 64), LDS_BYTES, stream, a); }
#else
    a.ph_lo = 0; a.ph_hi = N_PHASES;
    hipLaunchKernelGGL(mk_fwd, dim3(grid), dim3(NWAVES * 64), LDS_BYTES, stream, a);
#endif
    const hipError_t le = hipPeekAtLastError();
    if (le != hipSuccess) fprintf(stderr, "kernel_launch: launch failed: %s\n", hipGetErrorName(le));
}
```

```cpp
#include <hip/hip_runtime.h>
#include <cstdio>
#include <cstdint>

#ifndef MK_PER_PHASE
#define MK_PER_PHASE 0
#endif

#ifndef EXTRA_BARS
#define EXTRA_BARS 0
#endif
#ifndef DUP_MASK
#define DUP_MASK 0
#endif

#define LAS __attribute__((address_space(3)))
#define GAS __attribute__((address_space(1)))
typedef unsigned short bf16_t;
typedef short bf16x8 __attribute__((ext_vector_type(8)));
typedef float f32x4 __attribute__((ext_vector_type(4)));
typedef float f32x2 __attribute__((ext_vector_type(2)));
typedef unsigned u32x4 __attribute__((ext_vector_type(4)));
typedef unsigned u32x2 __attribute__((ext_vector_type(2)));
typedef GAS unsigned gu32;

constexpr int D = 1024, NB = 2, T = 8192, CT = 256, NL = 2, DIN = 8192;
constexpr int ML = NB * T;
constexpr int MC = NB * CT;
constexpr int M = ML + MC;
constexpr float RMS_EPS = 1e-6f;
constexpr float LOG2E = 1.4426950408889634f;

constexpr size_t MiB = 1u << 20;
constexpr size_t WS_CTL = 0, CTL_ZERO_BYTES = 4 * MiB;
constexpr size_t WS_MOD = 1 * MiB;
constexpr size_t WS_CLAM = WS_MOD + 128 * 1024;
constexpr size_t WS_CTX1 = 4 * MiB;
constexpr size_t WS_W1T = 6 * MiB;
constexpr size_t WS_WABT = 38 * MiB;
constexpr size_t WS_WOT = 46 * MiB;
constexpr size_t WS_GWT = 50 * MiB;
constexpr size_t WS_BIG = 52 * MiB;
constexpr size_t WS_XC = 118 * MiB;
constexpr size_t WS_SZB = 151 * MiB;
constexpr size_t WS_RAT = 184 * MiB;
constexpr size_t WS_SMB = 217 * MiB;
constexpr size_t WS_GRAN = 1 * MiB + 512 * 1024;
constexpr size_t GRAN_BYTES = 2 * MiB + 256 * 1024;
constexpr size_t WS_GWTC = 253 * MiB;
constexpr size_t WS_END = 255 * MiB;
static_assert(WS_CLAM + NL * 2 * 1024 * 4 <= WS_GRAN && WS_GRAN + GRAN_BYTES <= WS_CTX1 && (size_t)(3 * 33 * 16 * 128 + 66 * 256 * 4) * 8 <= GRAN_BYTES && WS_CTX1 >= CTL_ZERO_BYTES, "ws map");
static_assert((size_t)M * 1024 * 2 == 33 * MiB, "ws map");

constexpr int CW_BAR = 4096;
constexpr int CW_CG2CNT = 320, CW_CG3CNT = 384;
constexpr int CW_CTXCNT = 192;
constexpr int CW_PANCNT = 8192;
constexpr int CW_PTMO = 64;
constexpr int GR_N = 33 * 16 * 128;

constexpr int RING_BYTES = 131072;
constexpr int MISC_OFF = RING_BYTES;
constexpr int SCR_OFF = RING_BYTES + 512;
constexpr int LDS_BYTES = 147456;
constexpr int NWAVES = 8;

__device__ __forceinline__ unsigned cvt_pk_bf16(float lo, float hi) { unsigned r; asm volatile("v_cvt_pk_bf16_f32 %0, %1, %2" : "=v"(r) : "v"(lo), "v"(hi)); return r; }
__device__ __forceinline__ float bf_lo(unsigned w) { return __uint_as_float(w << 16); }
__device__ __forceinline__ float bf_hi(unsigned w) { return __uint_as_float(w & 0xffff0000u); }
__device__ __forceinline__ f32x4 unpack4(u32x2 w) { return (f32x4){bf_lo(w.x), bf_hi(w.x), bf_lo(w.y), bf_hi(w.y)}; }
__device__ __forceinline__ u32x2 pack4(f32x4 v) { u32x2 w; w.x = cvt_pk_bf16(v[0], v[1]); w.y = cvt_pk_bf16(v[2], v[3]); return w; }
__device__ __forceinline__ float sigmoidf_(float x) { return __builtin_amdgcn_rcpf(1.0f + __builtin_amdgcn_exp2f(-x * LOG2E)); }
__device__ __forceinline__ f32x4 exp2_4(f32x4 t) { return (f32x4){__builtin_amdgcn_exp2f(t[0]), __builtin_amdgcn_exp2f(t[1]), __builtin_amdgcn_exp2f(t[2]), __builtin_amdgcn_exp2f(t[3])}; }
__device__ __forceinline__ f32x4 rcp4(f32x4 t) { return (f32x4){__builtin_amdgcn_rcpf(t[0]), __builtin_amdgcn_rcpf(t[1]), __builtin_amdgcn_rcpf(t[2]), __builtin_amdgcn_rcpf(t[3])}; }
__device__ __forceinline__ f32x4 rsq4(f32x4 t) { return (f32x4){__builtin_amdgcn_rsqf(t[0]), __builtin_amdgcn_rsqf(t[1]), __builtin_amdgcn_rsqf(t[2]), __builtin_amdgcn_rsqf(t[3])}; }
__device__ __forceinline__ f32x4 sqrt4(f32x4 t) { return (f32x4){__builtin_amdgcn_sqrtf(t[0]), __builtin_amdgcn_sqrtf(t[1]), __builtin_amdgcn_sqrtf(t[2]), __builtin_amdgcn_sqrtf(t[3])}; }
__device__ __forceinline__ float opaque_f(float x) { asm("" : "+s"(x)); return x; }
__device__ __forceinline__ f32x4 sigmoid4(f32x4 x) { return rcp4(exp2_4(x * opaque_f(-LOG2E)) + 1.0f); }
__device__ __forceinline__ f32x4 silu4(f32x4 x) { return x * sigmoid4(x); }
template <int CTRL> __device__ __forceinline__ float dppf(float old, float src) {
    return __builtin_bit_cast(float, __builtin_amdgcn_update_dpp(__builtin_bit_cast(int, old), __builtin_bit_cast(int, src), CTRL, 0xf, 0xf, false));
}
template <int CTRL> __device__ __forceinline__ f32x4 dpp4(f32x4 old, f32x4 s) { return (f32x4){dppf<CTRL>(old[0], s[0]), dppf<CTRL>(old[1], s[1]), dppf<CTRL>(old[2], s[2]), dppf<CTRL>(old[3], s[3])}; }
#define DPP_ROR(n) (0x120 + (n))
#define DPP_SHR(n) (0x110 + (n))
#define DPP_SHL(n) (0x100 + (n))
#define DPP_BCAST(n) (0x150 + (n))
__device__ __forceinline__ f32x4 sel4(bool c, f32x4 a, f32x4 b) { return c ? a : b; }
__device__ __forceinline__ int fresh_lane() { unsigned z; asm volatile("s_mov_b32 %0, 0" : "=s"(z)); return (int)__builtin_amdgcn_mbcnt_hi(~0u, __builtin_amdgcn_mbcnt_lo(~0u, z)); }
#define LDS_WAIT() asm volatile("s_waitcnt lgkmcnt(0)" ::: "memory")
#define VM_WAIT() asm volatile("s_waitcnt vmcnt(0)" ::: "memory")
#define WG_BAR() do { asm volatile("s_waitcnt lgkmcnt(0)" ::: "memory"); __builtin_amdgcn_s_barrier(); asm volatile("" ::: "memory"); } while (0)

namespace pg8 {
constexpr int BM = 256, BK = 64, HALF = 128, HTB = HALF * BK * 2, STAGE_BYTES = 8 * HTB, NXCD = 8;
#ifndef WGM_DEFAULT
#define WGM_DEFAULT 6
#endif
#ifndef WGM_G23
#define WGM_G23 4
#endif
constexpr int WGM_UNUSED = 0;
__host__ __device__ __forceinline__ int lds_byte(int r, int c) { const int st = (r >> 4) * 2 + (c >> 5), rr = r & 15, cc = c & 31, ob = rr * 64 + cc * 2; return st * 1024 + (ob ^ (((ob >> 9) & 1) << 5)); }
__host__ __device__ __forceinline__ void stage_rc(int b, int& R, int& C) { const int st = b / 1024, sb = b % 1024, swz = sb ^ (((sb >> 9) & 1) << 5); R = (st >> 1) * 16 + swz / 64; C = (st & 1) * 32 + (swz % 64) / 2; }

struct Unit { int pm, pn, kk, pos, bb, plo; };
struct Gemm {
    const bf16_t* A; const bf16_t* Bt; int lda, ldb, K; int a_kk, b_kk; int a_pn_shift, a_pn_mul; int a_perm;
    __device__ __forceinline__ const char* a_ptr(const Unit& u) const { return (const char*)(A + (size_t)u.pm * 256 * lda + (size_t)u.kk * a_kk + (size_t)(u.pn >> a_pn_shift) * a_pn_mul); }
    __device__ __forceinline__ const char* b_ptr(const Unit& u) const { return (const char*)(Bt + (size_t)u.pn * 256 * ldb + (size_t)u.kk * b_kk); }
};
struct Sched {
    int nM, nN, G, c, kdiv, nmain, extra_n, extra_pm0, extra_pn0, extra_npn, pass_dir, extra_first, list_off, extra_sh, late_n, late_r, wgm;
    __device__ __forceinline__ void init(int nM_, int nN_, int G_, int c_, int kdiv_ = 1, int extra_n_ = 0, int epm0 = 0, int epn0 = 0, int enpn = 1) {
        nM = nM_; nN = nN_; G = G_; c = c_; kdiv = kdiv_; nmain = nM * nN; extra_n = extra_n_; extra_pm0 = epm0; extra_pn0 = epn0; extra_npn = enpn; pass_dir = -1; extra_first = 0; list_off = -1; extra_sh = 31 - __builtin_clz((unsigned)enpn); late_n = 0; late_r = 0; wgm = WGM_DEFAULT; }
    __device__ __forceinline__ void init_pass(int G_, int c_, int dir) { init(0, 1, G_, c_); pass_dir = dir; }
    __device__ __forceinline__ bool next(int i, Unit& u) const {
        u.pos = 0; u.bb = 0; u.plo = 0;
        if (pass_dir >= 0) {
            const int L = i * G + c; if (L >= 32 * 16) return false;
            const int pos = (L >> 4) + 1, bb = L & 15, b = bb >> 3;
            u.pm = pass_dir == 0 ? 32 * b + pos - 1 : 32 * b + 32 - pos; u.pn = bb & 7; u.kk = 0;
            u.pos = pos; u.bb = bb; u.plo = ((i * G - bb + 15) >> 4) + 1; return true;
        }
        const int ti = (kdiv == 2) ? (i >> 1) : i; u.kk = (kdiv == 2) ? (i & 1) : 0;
        if (list_off >= 0) {
            const int e = ti * G + c - list_off; if (e < 0 || e >= extra_n) return false;
            u.pm = extra_pm0 + (e >> extra_sh); u.pn = extra_pn0 + (e & (extra_npn - 1)); return true;
        }
        long L = (long)ti * G + c;
        if (late_n > 0) {
            if (c < late_n) {
                if (i == 0) { u.pm = 64 + (c >> 2); u.pn = 16 + (c & 3); return true; }
                L = (long)late_r * (G - late_n) + (long)(i - 1) * G + c;
            } else L = i < late_r ? (long)i * (G - late_n) + (c - late_n) : (long)late_r * (G - late_n) + (long)(i - late_r) * G + c;
            if (L >= nmain) return false;
        }
        if (extra_first) {
            if (L < extra_n) { const int e = (int)L; u.pm = extra_pm0 + (e >> extra_sh); u.pn = extra_pn0 + (e & (extra_npn - 1)); return true; }
            L -= extra_n; if (L >= nmain) return false;
        }
        if (L < nmain) {
            int wgid = (int)L; { const int q = nmain / NXCD, r = nmain % NXCD, xcd = wgid % NXCD, off = wgid / NXCD; wgid = (xcd < r ? xcd * (q + 1) : r * (q + 1) + (xcd - r) * q) + off; }
            const int nig = wgm * nN, gid = wgid / nig, fm = gid * wgm, gsz = (nM - fm) < wgm ? (nM - fm) : wgm;
            u.pm = fm + ((wgid % nig) % gsz); u.pn = (wgid % nig) / gsz; return true;
        }
        const int e = (int)(L - nmain); if (e >= extra_n) return false;
        u.pm = extra_pm0 + (e >> extra_sh); u.pn = extra_pn0 + (e & (extra_npn - 1)); return true;
    }
};

template <class T, class = void> struct epi_after_drain { static constexpr bool value = false; };
template <class T> struct epi_after_drain<T, decltype((void)T::AFTER_DRAIN)> { static constexpr bool value = T::AFTER_DRAIN; };
template <class Epi>
__device__ __forceinline__ void gemm_phase(LAS unsigned char* lds, const Gemm g, const Sched& S, const Epi& E, int wave_) {
    const int tid_ = fresh_lane() + wave_ * 64;
    const int tid = tid_, wid = __builtin_amdgcn_readfirstlane(tid >> 6), lane = tid & 63, wr = wid >> 2, wc = wid & 3, fr = lane & 15, fq = lane >> 4;
    int K_ = g.K; asm volatile("" : "+s"(K_));
    const int K = K_, nt = K / BK;
    unsigned voffA, voffB;
    { int R, C; stage_rc(tid * 16, R, C); const int Rp = g.a_perm ? 4 * (R & 15) + (R >> 4) : R; voffA = (unsigned)(Rp * g.lda + C) * 2u; voffB = (unsigned)(R * g.ldb + C) * 2u; }
    const size_t qvoffA = (size_t)64 * g.lda * 2, qvoffB = (size_t)64 * g.ldb * 2;
    const size_t kstep = (size_t)(BK * 2);
    const size_t hstepA = (size_t)HALF * g.lda * 2, hstepB = (size_t)HALF * g.ldb * 2;
    const unsigned ldsw = (unsigned)wid * 1024u;
    const int aoff = lds_byte(wr * 64 + fr, fq * 8), boff = lds_byte(wc * 32 + fr, fq * 8);
#define PG8_SA(b, h) (((b) * 2 + (h)) * HTB)
#define PG8_SB(b, h) ((4 + (b) * 2 + (h)) * HTB)
#define PG8_STAGE(bufoff, gbase, voff) do { _Pragma("unroll") for (int _i = 0; _i < 2; ++_i) \
        __builtin_amdgcn_global_load_lds((const unsigned*)((const char*)(gbase) + (size_t)_i * q##voff + (voff)), (LAS unsigned*)(lds + (bufoff) + ldsw + _i * 8192), 16, 0, 0); } while (0)
#define PG8_LDA(dst, b, h) do { _Pragma("unroll") for (int m = 0; m < 4; ++m) _Pragma("unroll") for (int k = 0; k < 2; ++k) dst[m][k] = *(const LAS bf16x8*)(lds + PG8_SA(b, h) + aoff + m * 2048 + k * 1024); } while (0)
#define PG8_LDB(dst, b, h) do { _Pragma("unroll") for (int n = 0; n < 2; ++n) _Pragma("unroll") for (int k = 0; k < 2; ++k) dst[n][k] = *(const LAS bf16x8*)(lds + PG8_SB(b, h) + boff + n * 2048 + k * 1024); } while (0)
#define PG8_MMA(ai, bj, At, Bt) do { __builtin_amdgcn_s_setprio(1); _Pragma("unroll") for (int m = 0; m < 4; ++m) _Pragma("unroll") for (int n = 0; n < 2; ++n) _Pragma("unroll") for (int k = 0; k < 2; ++k) \
        acc[ai][bj][m][n] = __builtin_amdgcn_mfma_f32_16x16x32_bf16(Bt[n][k], At[m][k], acc[ai][bj][m][n], 0, 0, 0); __builtin_amdgcn_s_setprio(0); } while (0)
#define PG8_WAIT_V(n) asm volatile("s_waitcnt vmcnt(" #n ")" ::: "memory")
#define PG8_WAIT_L(n) asm volatile("s_waitcnt lgkmcnt(" #n ")" ::: "memory")
#define PG8_BAR __builtin_amdgcn_s_barrier()
#define PG8_SCHED __builtin_amdgcn_sched_barrier(0)
    Unit cur, nxt; int ui = 0;
    if (!S.next(0, cur)) return;
    f32x4 acc[2][2][4][2];
#pragma unroll
    for (int a = 0; a < 2; ++a)
#pragma unroll
        for (int b = 0; b < 2; ++b)
#pragma unroll
            for (int m = 0; m < 4; ++m)
#pragma unroll
                for (int n = 0; n < 2; ++n) acc[a][b][m][n] = (f32x4){0.f, 0.f, 0.f, 0.f};
    bf16x8 At[4][2], B0[2][2], B1[2][2];
    const char* cA = g.a_ptr(cur); const char* cB = g.b_ptr(cur);
    PG8_STAGE(PG8_SB(0, 0), cB, voffB); PG8_STAGE(PG8_SB(0, 1), cB + hstepB, voffB); PG8_STAGE(PG8_SA(0, 0), cA, voffA); PG8_STAGE(PG8_SA(0, 1), cA + hstepA, voffA);
    if (wr == 1) PG8_BAR;
    PG8_WAIT_V(2); PG8_BAR;
    PG8_STAGE(PG8_SB(1, 0), cB + kstep, voffB); PG8_STAGE(PG8_SA(1, 0), cA + kstep, voffA); PG8_STAGE(PG8_SB(1, 1), cB + hstepB + kstep, voffB);
    PG8_WAIT_V(6); PG8_BAR;
    for (;;) {
        const bool has_next = S.next(ui + 1, nxt);
        const char* nA = has_next ? g.a_ptr(nxt) : cA; const char* nB = has_next ? g.b_ptr(nxt) : cB;
        for (int t = 0; t < nt; t += 2) {
            const bool last = (t == nt - 2);
            const char* a1 = cA + (size_t)(t + 1) * kstep;
            const char* a2 = last ? nA : cA + (size_t)(t + 2) * kstep; const char* b2 = last ? nB : cB + (size_t)(t + 2) * kstep;
            const char* a3 = a2 + kstep; const char* b3 = b2 + kstep;
            PG8_LDB(B0, 0, 0); PG8_LDB(B1, 0, 1); PG8_SCHED; PG8_LDA(At, 0, 0); PG8_STAGE(PG8_SA(1, 1), a1 + hstepA, voffA);
            PG8_WAIT_V(8); PG8_WAIT_L(0); PG8_BAR; PG8_MMA(0, 0, At, B0); PG8_MMA(0, 1, At, B1); PG8_BAR; PG8_SCHED;
            PG8_LDA(At, 0, 1); PG8_STAGE(PG8_SB(0, 0), b2, voffB); PG8_STAGE(PG8_SB(0, 1), b2 + hstepB, voffB); PG8_STAGE(PG8_SA(0, 0), a2, voffA);
            PG8_WAIT_V(8); PG8_WAIT_L(0); PG8_BAR; PG8_MMA(1, 0, At, B0); PG8_MMA(1, 1, At, B1); PG8_BAR; PG8_SCHED;
            PG8_LDB(B0, 1, 0); PG8_LDB(B1, 1, 1); PG8_SCHED; PG8_LDA(At, 1, 0); PG8_STAGE(PG8_SA(0, 1), a2 + hstepA, voffA);
            PG8_WAIT_V(8); PG8_WAIT_L(0); PG8_BAR; PG8_MMA(0, 0, At, B0); PG8_MMA(0, 1, At, B1); PG8_BAR; PG8_SCHED;
            PG8_LDA(At, 1, 1); PG8_STAGE(PG8_SB(1, 0), b3, voffB); PG8_STAGE(PG8_SB(1, 1), b3 + hstepB, voffB); PG8_STAGE(PG8_SA(1, 0), a3, voffA);
            PG8_WAIT_V(8); PG8_WAIT_L(0); PG8_BAR; PG8_MMA(1, 0, At, B0); PG8_MMA(1, 1, At, B1); PG8_BAR; PG8_SCHED;
        }
        if (wr == 0) PG8_BAR;
        const int eln = fresh_lane();
        const int efr = eln & 15, efq = eln >> 4; int ewr = wr, ewc = wc; asm volatile("" : "+s"(ewr), "+s"(ewc));
        bool keep = false;
        if constexpr (!epi_after_drain<Epi>::value) keep = E(acc, cur, ewr, ewc, efr, efq);
        if (!has_next) break;
        if (!keep) {
#pragma unroll
            for (int a = 0; a < 2; ++a)
#pragma unroll
                for (int b = 0; b < 2; ++b)
#pragma unroll
                    for (int m = 0; m < 4; ++m)
#pragma unroll
                        for (int n = 0; n < 2; ++n) acc[a][b][m][n] = (f32x4){0.f, 0.f, 0.f, 0.f};
        }
        cur = nxt; cA = nA; cB = nB; ++ui;
        if (wr == 1) PG8_BAR;
    }
    PG8_WAIT_V(0);
    PG8_BAR;
    if constexpr (epi_after_drain<Epi>::value) { const int eln = fresh_lane(); int ewr = wr, ewc = wc; asm volatile("" : "+s"(ewr), "+s"(ewc)); E.final(acc, cur, ewr, ewc, eln, lds); }
#undef PG8_SA
#undef PG8_SB
#undef PG8_STAGE
#undef PG8_LDA
#undef PG8_LDB
#undef PG8_MMA
#undef PG8_WAIT_V
#undef PG8_WAIT_L
#undef PG8_BAR
#undef PG8_SCHED
}

template <class Epi>
__device__ __forceinline__ void pass_phase(LAS unsigned char* lds, const Gemm g, const Sched& S, const Epi& E, int wave_) {
    const int tid = fresh_lane() + wave_ * 64;
    const int wid = __builtin_amdgcn_readfirstlane(tid >> 6), lane = tid & 63, wr = wid >> 2, wc = wid & 3, fr = lane & 15, fq = lane >> 4;
    unsigned voffA, voffB;
    { int R, C; stage_rc(tid * 16, R, C); voffA = (unsigned)((4 * (R & 15) + (R >> 4)) * g.lda + C) * 2u; voffB = (unsigned)(R * g.ldb + C) * 2u; }
    const size_t qvoffA = (size_t)64 * g.lda * 2, qvoffB = (size_t)64 * g.ldb * 2;
    const size_t kstep = (size_t)(BK * 2), hstepA = (size_t)HALF * g.lda * 2, hstepB = (size_t)HALF * g.ldb * 2;
    const unsigned ldsw = (unsigned)wid * 1024u;
    const int aoff = lds_byte(wr * 64 + fr, fq * 8), boff = lds_byte(wc * 32 + fr, fq * 8);
#define PP_SA(b, h) (((b) * 2 + (h)) * HTB)
#define PP_SB(b, h) ((4 + (b) * 2 + (h)) * HTB)
#define PP_STAGE(bufoff, gbase, voff) do { _Pragma("unroll") for (int _i = 0; _i < 2; ++_i) \
        __builtin_amdgcn_global_load_lds((const unsigned*)((const char*)(gbase) + (size_t)_i * q##voff + (voff)), (LAS unsigned*)(lds + (bufoff) + ldsw + _i * 8192), 16, 0, 0); } while (0)
#define PP_STAGE_A(ap) do { PP_STAGE(PP_SA(0, 0), (ap), voffA); PP_STAGE(PP_SA(0, 1), (ap) + hstepA, voffA); PP_STAGE(PP_SA(1, 0), (ap) + kstep, voffA); PP_STAGE(PP_SA(1, 1), (ap) + hstepA + kstep, voffA); } while (0)
#define PP_STAGE_B(bp) do { PP_STAGE(PP_SB(0, 0), (bp), voffB); PP_STAGE(PP_SB(0, 1), (bp) + hstepB, voffB); PP_STAGE(PP_SB(1, 0), (bp) + kstep, voffB); PP_STAGE(PP_SB(1, 1), (bp) + hstepB + kstep, voffB); } while (0)
    Unit cur, nxt; int ui = 0;
    if (!S.next(0, cur)) return;
    PP_STAGE_B(g.b_ptr(cur)); PP_STAGE_A(g.a_ptr(cur));
    for (;;) {
        const bool has_next = S.next(ui + 1, nxt);
        asm volatile("s_waitcnt vmcnt(0)" ::: "memory"); __builtin_amdgcn_s_barrier(); asm volatile("" ::: "memory");
        f32x4 acc[2][2][4][2];
#pragma unroll
        for (int a = 0; a < 2; ++a)
#pragma unroll
            for (int b = 0; b < 2; ++b)
#pragma unroll
                for (int m = 0; m < 4; ++m)
#pragma unroll
                    for (int n = 0; n < 2; ++n) acc[a][b][m][n] = (f32x4){0.f, 0.f, 0.f, 0.f};
#pragma unroll
        for (int b = 0; b < 2; ++b) {
            bf16x8 B0[2][2], B1[2][2];
#pragma unroll
            for (int n = 0; n < 2; ++n)
#pragma unroll
                for (int k = 0; k < 2; ++k) { B0[n][k] = *(const LAS bf16x8*)(lds + PP_SB(b, 0) + boff + n * 2048 + k * 1024); B1[n][k] = *(const LAS bf16x8*)(lds + PP_SB(b, 1) + boff + n * 2048 + k * 1024); }
#pragma unroll
            for (int h = 0; h < 2; ++h) {
                bf16x8 At[4][2];
#pragma unroll
                for (int m = 0; m < 4; ++m)
#pragma unroll
                    for (int k = 0; k < 2; ++k) At[m][k] = *(const LAS bf16x8*)(lds + PP_SA(b, h) + aoff + m * 2048 + k * 1024);
#pragma unroll
                for (int m = 0; m < 4; ++m)
#pragma unroll
                    for (int n = 0; n < 2; ++n)
#pragma unroll
                        for (int k = 0; k < 2; ++k) { acc[h][0][m][n] = __builtin_amdgcn_mfma_f32_16x16x32_bf16(B0[n][k], At[m][k], acc[h][0][m][n], 0, 0, 0);
                                                      acc[h][1][m][n] = __builtin_amdgcn_mfma_f32_16x16x32_bf16(B1[n][k], At[m][k], acc[h][1][m][n], 0, 0, 0); }
            }
        }
        struct AfterGates { LAS unsigned char* lds; const char* nA; const char* nB; unsigned voffA, voffB, ldsw; size_t qvoffA, qvoffB, kstep, hstepA, hstepB; bool stage_a, stage_b;
            __device__ __forceinline__ void operator()() const {
                asm volatile("s_waitcnt lgkmcnt(0)" ::: "memory"); __builtin_amdgcn_s_barrier(); asm volatile("" ::: "memory");
                if (stage_b) PP_STAGE_B(nB);
                if (stage_a) PP_STAGE_A(nA);
            } };
        const AfterGates ag{lds, has_next ? g.a_ptr(nxt) : nullptr, has_next ? g.b_ptr(nxt) : nullptr, voffA, voffB, ldsw, qvoffA, qvoffB, kstep, hstepA, hstepB, has_next, has_next && (nxt.pn != cur.pn)};
        int eln = fresh_lane(); const int efr = eln & 15, efq = eln >> 4; int ewr = wr, ewc = wc; asm volatile("" : "+s"(ewr), "+s"(ewc));
        E.run(acc, cur, ewr, ewc, efr, efq, ag);
        if (!has_next) break;
        cur = nxt; ++ui;
    }
    asm volatile("s_waitcnt vmcnt(0)" ::: "memory"); __builtin_amdgcn_s_barrier();
#undef PP_SA
#undef PP_SB
#undef PP_STAGE
#undef PP_STAGE_A
#undef PP_STAGE_B
}
}
using pg8::Unit;
typedef f32x4 Acc[2][2][4][2];

struct EpiG1 {
    bf16_t* BIG; bf16_t* XC; bf16_t* SZB; bf16_t* RAT; bf16_t* SMB;
    const float* w3; const float* w4; const float* b4;
    LAS float* scr;
    unsigned* ctxcnt;
    __device__ __forceinline__ bool operator()(Acc& acc, const Unit& u, int wr, int wc, int fr, int fq) const {
        const int pm = u.pm, pn = u.pn;
        const bool isctx = pm >= 64;
        const unsigned row0 = (unsigned)pm * 256 + wr * 64 + 4 * fr;
        const f32x4 zero4 = (f32x4){0.f, 0.f, 0.f, 0.f};
        if (pn < 16) {
            const int ch0 = 64 * pn + 16 * wc + 4 * fq;
            const f32x4 w0 = *(const f32x4*)(w3 + ch0), w1 = *(const f32x4*)(w3 + 1024 + ch0), w2 = *(const f32x4*)(w3 + 2048 + ch0);
#pragma unroll
            for (int ai = 0; ai < 2; ++ai)
#pragma unroll
                for (int m = 0; m < 4; ++m) acc[ai][0][m][0] = acc[ai][0][m][0] * acc[ai][0][m][1];
            const int col = 16 * wc + 4 * fq;
            if (isctx) {
#pragma unroll
                for (int ai = 0; ai < 2; ++ai) { const int seg = 2 * ai + wr;
                    if (fr == 0) *(LAS f32x4*)(scr + (seg * 2 + 0) * 64 + col) = acc[ai][0][0][0];
                    if (fr == 15) *(LAS f32x4*)(scr + (seg * 2 + 1) * 64 + col) = acc[ai][0][3][0]; }
                WG_BAR();
            }
#pragma unroll
            for (int ai = 0; ai < 2; ++ai) {
                const int seg = 2 * ai + wr;
                f32x4 hp = zero4, hn = zero4;
                if (isctx) { if (seg > 0) hp = *(const LAS f32x4*)(scr + ((seg - 1) * 2 + 1) * 64 + col); if (seg < 3) hn = *(const LAS f32x4*)(scr + ((seg + 1) * 2 + 0) * 64 + col); }
                const f32x4 pl = dpp4<DPP_SHR(1)>(hp, acc[ai][0][3][0]);
                const f32x4 nf = dpp4<DPP_SHL(1)>(hn, acc[ai][0][0][0]);
#pragma unroll
                for (int m = 0; m < 4; ++m) {
                    const f32x4 prev = m > 0 ? acc[ai][0][m > 0 ? m - 1 : 0][0] : pl;
                    const f32x4 next = m < 3 ? acc[ai][0][m < 3 ? m + 1 : 3][0] : nf;
                    const f32x4 cv = w0 * prev + w1 * acc[ai][0][m][0] + w2 * next;
                    const f32x4 y = acc[ai][1][m][0] * cv * silu4(acc[ai][1][m][1]);
                    *(u32x2*)(BIG + (size_t)(row0 + ai * 128 + m) * 2048 + ch0) = pack4(y);
                }
            }
            if (isctx) WG_BAR();
        } else if (pn < 20) {
            if (isctx) {
#pragma unroll
                for (int ai = 0; ai < 2; ++ai) { const int seg = 2 * ai + wr;
#pragma unroll
                    for (int bj = 0; bj < 2; ++bj)
#pragma unroll
                        for (int n = 0; n < 2; ++n) { const int col = 128 * bj + 32 * wc + 16 * n + 4 * fq;
                            if (fr == 0) *(LAS f32x4*)(scr + (seg * 3 + 0) * 256 + col) = acc[ai][bj][0][n];
                            if (fr == 15) *(LAS f32x4*)(scr + (seg * 3 + 1) * 256 + col) = acc[ai][bj][2][n];
                            if (fr == 15) *(LAS f32x4*)(scr + (seg * 3 + 2) * 256 + col) = acc[ai][bj][3][n]; } }
                WG_BAR();
            }
#pragma unroll
            for (int bj = 0; bj < 2; ++bj) {
                const int ch0 = 256 * (pn - 16) + 128 * bj + 32 * wc + 8 * fq;
#pragma unroll
                for (int ai = 0; ai < 2; ++ai) {
                    const int seg = 2 * ai + wr;
                    u32x2 pk[4];
#pragma unroll
                    for (int n = 0; n < 2; ++n) {
                        const int ch = ch0 + 4 * n, col = 128 * bj + 32 * wc + 16 * n + 4 * fq;
                        const f32x4 k0 = *(const f32x4*)(w4 + ch), k1 = *(const f32x4*)(w4 + 1024 + ch), k2 = *(const f32x4*)(w4 + 2048 + ch), k3 = *(const f32x4*)(w4 + 3072 + ch), kb = *(const f32x4*)(b4 + ch);
                        f32x4 hp1 = zero4, hp2 = zero4, hn1 = zero4;
                        if (isctx) {
                            if (seg > 0) { hp2 = *(const LAS f32x4*)(scr + ((seg - 1) * 3 + 1) * 256 + col); hp1 = *(const LAS f32x4*)(scr + ((seg - 1) * 3 + 2) * 256 + col); }
                            if (seg < 3) hn1 = *(const LAS f32x4*)(scr + ((seg + 1) * 3 + 0) * 256 + col); }
                        const f32x4 s3 = dpp4<DPP_SHR(1)>(hp1, acc[ai][bj][3][n]), s2 = dpp4<DPP_SHR(1)>(hp2, acc[ai][bj][2][n]);
                        const f32x4 nx = dpp4<DPP_SHL(1)>(hn1, acc[ai][bj][0][n]);
#pragma unroll
                        for (int m = 0; m < 4; ++m) {
                            const f32x4 x = acc[ai][bj][m][n];
                            const f32x4 p1 = m > 0 ? acc[ai][bj][m > 0 ? m - 1 : 0][n] : s3;
                            const f32x4 p2 = m > 1 ? acc[ai][bj][m > 1 ? m - 2 : 0][n] : (m == 1 ? s3 : s2);
                            const f32x4 n1 = m < 3 ? acc[ai][bj][m < 3 ? m + 1 : 3][n] : nx;
                            const f32x4 o = k0 * p2 + k1 * p1 + k2 * x + k3 * n1 + kb;
                            if (n == 0) pk[m] = pack4(o);
                            else { const u32x2 b = pack4(o); *(u32x4*)(XC + (size_t)(row0 + ai * 128 + m) * 1024 + ch0) = (u32x4){pk[m].x, pk[m].y, b.x, b.y}; }
                        }
                    }
                }
            }
            if (isctx) WG_BAR();
        } else if (pn < 24) {
#pragma unroll
            for (int bj = 0; bj < 2; ++bj) { const int ch0 = 256 * (pn - 20) + 128 * bj + 32 * wc + 8 * fq;
#pragma unroll
                for (int ai = 0; ai < 2; ++ai)
#pragma unroll
                    for (int m = 0; m < 4; ++m) { const u32x2 a = pack4(silu4(acc[ai][bj][m][0])), b = pack4(silu4(acc[ai][bj][m][1]));
                        *(u32x4*)(SZB + (size_t)(row0 + ai * 128 + m) * 1024 + ch0) = (u32x4){a.x, a.y, b.x, b.y}; } }
        } else {
            const int ch0 = 128 * (pn - 24) + 32 * wc + 8 * fq;
#pragma unroll
            for (int ai = 0; ai < 2; ++ai)
#pragma unroll
                for (int m = 0; m < 4; ++m) {
                    const float nl = opaque_f(-LOG2E);
                    const f32x4 pa0 = exp2_4(acc[ai][0][m][0] * nl) + 1.0f, pa1 = exp2_4(acc[ai][0][m][1] * nl) + 1.0f, pb0 = exp2_4(acc[ai][1][m][0] * nl) + 1.0f, pb1 = exp2_4(acc[ai][1][m][1] * nl) + 1.0f;
                    const f32x4 sb0 = rcp4(pb0), sb1 = rcp4(pb1);
                    const f32x4 q0 = pb0 * rcp4(pa0), q1 = pb1 * rcp4(pa1);
                    const size_t off = (size_t)(row0 + ai * 128 + m) * 1024 + ch0;
                    { const u32x2 a = pack4(q0), b = pack4(q1); *(u32x4*)(RAT + off) = (u32x4){a.x, a.y, b.x, b.y}; }
                    { const u32x2 a = pack4(sb0), b = pack4(sb1); *(u32x4*)(SMB + off) = (u32x4){a.x, a.y, b.x, b.y}; }
                }
        }
        if (isctx) {
            asm volatile("s_waitcnt vmcnt(0)" ::: "memory"); WG_BAR();
            if (wr == 0 && wc == 0 && fq == 0 && fr == 0) { __builtin_amdgcn_fence(__ATOMIC_RELEASE, "agent"); asm volatile("s_waitcnt vmcnt(0)" ::: "memory");
                __hip_atomic_fetch_add(ctxcnt, 1u, __ATOMIC_RELAXED, __HIP_MEMORY_SCOPE_AGENT); }
        }
        return false;
    }
};

typedef unsigned long long u64;
__device__ __forceinline__ void gr_store(u64* p, unsigned epoch, float v) { __hip_atomic_store(p, ((u64)epoch << 32) | (u64)__float_as_uint(v), __ATOMIC_RELAXED, __HIP_MEMORY_SCOPE_AGENT); }
__device__ __forceinline__ u64 gr_load(const u64* p) { return __hip_atomic_load(p, __ATOMIC_RELAXED, __HIP_MEMORY_SCOPE_AGENT); }
template <int DIR> struct EpiP {
    const bf16_t* XC; const bf16_t* SZB; bf16_t* BIG;
    const float* br; const float* bi; const float* clam;
    u64* gran; unsigned* tmo; unsigned epoch;
    LAS float* scr;
    const LAS unsigned char* xlds;
    template <class AfterGates> __device__ __forceinline__ bool run(Acc& acc, const Unit& u, int wr, int wc, int fr, int fq, const AfterGates& after_gates) const {
        const int pm = u.pm, blk = u.pn;
        const int cl = 32 * wc + 8 * fq; const unsigned chb = 128 * blk + cl;
        const unsigned row0 = (unsigned)pm * 256 + wr * 64 + 4 * fr;
        const int tq = (wr * 4 + wc) * 64 + fq * 16 + fr;
        u32x4 xw[2][4];
#pragma unroll
        for (int ai = 0; ai < 2; ++ai)
#pragma unroll
            for (int m = 0; m < 4; ++m) xw[ai][m] = *(const LAS u32x4*)(xlds + ((wc >> 1) * 2 + ai) * pg8::HTB + pg8::lds_byte(wr * 64 + 16 * m + fr, cl & 63));
        const float nl2e = opaque_f(-LOG2E), m1 = opaque_f(-1.0f);
#pragma unroll
        for (int n = 0; n < 2; ++n) {
            const int ch0 = chb + 4 * n;
            const f32x4 brv = *(const f32x4*)(br + ch0) * (-LOG2E), biv = *(const f32x4*)(bi + ch0) * (-LOG2E);
            const f32x4 cv = *(const f32x4*)(clam + ch0) * LOG2E;
#pragma unroll
            for (int ai = 0; ai < 2; ++ai)
#pragma unroll
                for (int m = 0; m < 4; ++m) {
                    const f32x4 x = unpack4(n == 0 ? (u32x2){xw[ai][m].x, xw[ai][m].y} : (u32x2){xw[ai][m].z, xw[ai][m].w});
                    const f32x4 tr = acc[ai][0][m][n] * nl2e + brv, ti = acc[ai][1][m][n] * nl2e + biv;
                    const f32x4 r = rcp4(exp2_4(tr) + 1.0f), pi = exp2_4(ti) + 1.0f;
                    const f32x4 a = exp2_4(cv * r);
                    const f32x4 w = (a * a) * m1 + 1.0f;
                    acc[ai][0][m][n] = a; acc[ai][1][m][n] = (w * rsq4((pi * pi) * w + 1e-30f)) * x;
                    __builtin_amdgcn_sched_barrier(0);
                }
        }
        after_gates();
#define SCAN_STEP(SH) \
        "v_fmac_f32_dpp %0, %0, %4 " SH " row_mask:0xf bank_mask:0xf\n\tv_fmac_f32_dpp %1, %1, %5 " SH " row_mask:0xf bank_mask:0xf\n\t" \
        "v_fmac_f32_dpp %2, %2, %6 " SH " row_mask:0xf bank_mask:0xf\n\tv_fmac_f32_dpp %3, %3, %7 " SH " row_mask:0xf bank_mask:0xf\n\t" \
        "v_mul_f32_dpp %4, %4, %4 " SH " row_mask:0xf bank_mask:0xf\n\tv_mul_f32_dpp %5, %5, %5 " SH " row_mask:0xf bank_mask:0xf\n\t" \
        "v_mul_f32_dpp %6, %6, %6 " SH " row_mask:0xf bank_mask:0xf\n\tv_mul_f32_dpp %7, %7, %7 " SH " row_mask:0xf bank_mask:0xf\n\t"
#define SCAN_CARRY(BC) \
        "v_fmac_f32_dpp %0, %8, %4 " BC " row_mask:0xf bank_mask:0xf\n\tv_fmac_f32_dpp %1, %9, %5 " BC " row_mask:0xf bank_mask:0xf\n\t" \
        "v_fmac_f32_dpp %2, %10, %6 " BC " row_mask:0xf bank_mask:0xf\n\tv_fmac_f32_dpp %3, %11, %7 " BC " row_mask:0xf bank_mask:0xf\n\t" \
        "v_mul_f32_dpp %4, %12, %4 " BC " row_mask:0xf bank_mask:0xf\n\tv_mul_f32_dpp %5, %13, %5 " BC " row_mask:0xf bank_mask:0xf\n\t" \
        "v_mul_f32_dpp %6, %14, %6 " BC " row_mask:0xf bank_mask:0xf\n\tv_mul_f32_dpp %7, %15, %7 " BC " row_mask:0xf bank_mask:0xf\n\t"
#define SCAN_OUT(A, L) "+v"(L[0]), "+v"(L[1]), "+v"(L[2]), "+v"(L[3]), "+v"(A[0]), "+v"(A[1]), "+v"(A[2]), "+v"(A[3])
#define SCAN_IN(A, L) "v"(L[0]), "v"(L[1]), "v"(L[2]), "v"(L[3]), "v"(A[0]), "v"(A[1]), "v"(A[2]), "v"(A[3])
#pragma unroll
        for (int ai = 0; ai < 2; ++ai) {
#pragma unroll
            for (int n = 0; n < 2; ++n) {
                if constexpr (DIR == 0) {
#pragma unroll
                    for (int m = 1; m < 4; ++m) { acc[ai][1][m][n] = acc[ai][0][m][n] * acc[ai][1][m - 1][n] + acc[ai][1][m][n]; acc[ai][0][m][n] = acc[ai][0][m][n] * acc[ai][0][m - 1][n]; }
                    asm volatile("s_nop 1\n\t" SCAN_STEP("row_shr:1") SCAN_STEP("row_shr:2") SCAN_STEP("row_shr:4") SCAN_STEP("row_shr:8") "s_nop 1" : SCAN_OUT(acc[ai][0][3][n], acc[ai][1][3][n]));
#pragma unroll
                    for (int m = 0; m < 3; ++m)
                        asm volatile("s_nop 1\n\t" SCAN_CARRY("row_shr:1") "s_nop 1" : SCAN_OUT(acc[ai][0][m][n], acc[ai][1][m][n]) : SCAN_IN(acc[ai][0][3][n], acc[ai][1][3][n]));
                } else {
#pragma unroll
                    for (int m = 2; m >= 0; --m) { acc[ai][1][m][n] = acc[ai][0][m][n] * acc[ai][1][m + 1][n] + acc[ai][1][m][n]; acc[ai][0][m][n] = acc[ai][0][m][n] * acc[ai][0][m + 1][n]; }
                    asm volatile("s_nop 1\n\t" SCAN_STEP("row_shl:1") SCAN_STEP("row_shl:2") SCAN_STEP("row_shl:4") SCAN_STEP("row_shl:8") "s_nop 1" : SCAN_OUT(acc[ai][0][0][n], acc[ai][1][0][n]));
#pragma unroll
                    for (int m = 1; m < 4; ++m)
                        asm volatile("s_nop 1\n\t" SCAN_CARRY("row_shl:1") "s_nop 1" : SCAN_OUT(acc[ai][0][m][n], acc[ai][1][m][n]) : SCAN_IN(acc[ai][0][0][n], acc[ai][1][0][n]));
                }
                const int seg = 2 * ai + wr;
                if (fr == (DIR == 0 ? 15 : 0)) {
#pragma unroll
                    for (int j = 0; j < 4; ++j) *(LAS f32x2*)(scr + (seg * 128 + cl + 4 * n + j) * 2) = (f32x2){acc[ai][0][DIR == 0 ? 3 : 0][n][j], acc[ai][1][DIR == 0 ? 3 : 0][n][j]};
                }
            }
        }
#undef SCAN_STEP
#undef SCAN_CARRY
#undef SCAN_OUT
#undef SCAN_IN
        u32x4 hfw[4], zw[4];
        if constexpr (DIR == 1) {
#pragma unroll
            for (int m = 0; m < 4; ++m) { const unsigned r = row0 + m; hfw[m] = *(const u32x4*)(BIG + (r * 2048u + 1024u + chb)); zw[m] = *(const u32x4*)(SZB + (r * 1024u + chb)); }
        }
        WG_BAR();
        {
            LAS float* part = scr + 1024; LAS float* car = scr + 2048;
            const int c = tq & 127, g = tq >> 7, pos = u.pos, npre = pos - u.plo;
            u64* const gA = gran + (size_t)u.bb * 128 + c; u64* const gB = gA + GR_N; u64* const gP = gA + 2 * GR_N;
            float At = 1.f, Bt = 0.f; f32x2 tb[4];
            if (tq < 128) {
#pragma unroll
                for (int s = 0; s < 4; ++s) { const int seg = DIR == 0 ? s : 3 - s; tb[s] = *(const LAS f32x2*)(scr + (seg * 128 + c) * 2); Bt = tb[s].x * Bt + tb[s].y; At = At * tb[s].x; }
                gr_store(gA + (size_t)pos * 2048, epoch, At); gr_store(gB + (size_t)pos * 2048, epoch, Bt);
            }
            float Ap = 1.f, Bp = 0.f, hbase = 0.f;
            {
                u64 ga[4], gb[4]; u64 gp = 0; const bool needp = (g == 0) && (u.plo > 0);
                unsigned spins = 0;
                for (;;) {
                    bool ok = true;
#pragma unroll
                    for (int i = 0; i < 4; ++i) { const int k = 4 * g + i; if (k < npre) { ga[i] = gr_load(gA + (size_t)(pos - 1 - k) * 2048); gb[i] = gr_load(gB + (size_t)(pos - 1 - k) * 2048); } else { ga[i] = 0; gb[i] = 0; } }
                    if (needp) gp = gr_load(((DIR == 1 && u.plo == 1) ? gA : gP) + (size_t)(u.plo - 1) * 2048);
#pragma unroll
                    for (int i = 0; i < 4; ++i) { const int k = 4 * g + i; if (k < npre) ok = ok && ((unsigned)(ga[i] >> 32) == epoch) && ((unsigned)(gb[i] >> 32) == epoch); }
                    if (needp) ok = ok && ((unsigned)(gp >> 32) == epoch);
                    if (ok) break;
                    __builtin_amdgcn_s_sleep(2);
                    if ((++spins & 63u) == 0u) { if (__hip_atomic_load(tmo, __ATOMIC_RELAXED, __HIP_MEMORY_SCOPE_AGENT) != 0u) break; if (spins > (1u << 16)) { __hip_atomic_store(tmo, 1u, __ATOMIC_RELAXED, __HIP_MEMORY_SCOPE_AGENT); break; } }
                }
#pragma unroll
                for (int i = 0; i < 4; ++i) { const int k = 4 * g + i; if (k < npre) { Bp = Ap * __uint_as_float((unsigned)gb[i]) + Bp; Ap = Ap * __uint_as_float((unsigned)ga[i]); } }
                if (needp) hbase = __uint_as_float((unsigned)gp);
            }
            *(LAS f32x2*)(part + (g * 128 + c) * 2) = (f32x2){Ap, Bp};
            WG_BAR();
            if (tq < 128) {
                float Aa = 1.f, Ba = 0.f;
#pragma unroll
                for (int g2 = 0; g2 < 4; ++g2) { const f32x2 p = *(const LAS f32x2*)(part + (g2 * 128 + c) * 2); Ba = Aa * p.y + Ba; Aa = Aa * p.x; }
                float h = Aa * hbase + Ba;
                gr_store(gP + (size_t)pos * 2048, epoch, At * h + Bt);
#pragma unroll
                for (int s = 0; s < 4; ++s) { const int seg = DIR == 0 ? s : 3 - s; car[seg * 128 + c] = h; h = tb[s].x * h + tb[s].y; }
            }
            WG_BAR();
#pragma unroll
            for (int ai = 0; ai < 2; ++ai) {
                const int seg = 2 * ai + wr;
                const f32x4 hs0 = *(const LAS f32x4*)(car + seg * 128 + cl), hs1 = *(const LAS f32x4*)(car + seg * 128 + cl + 4);
#pragma unroll
                for (int m = 0; m < 4; ++m) {
                    const unsigned r = row0 + ai * 128 + m;
                    f32x4 y0 = acc[ai][0][m][0] * hs0 + acc[ai][1][m][0], y1 = acc[ai][0][m][1] * hs1 + acc[ai][1][m][1];
                    if constexpr (DIR == 1) { y0 = (y0 + unpack4((u32x2){hfw[m].x, hfw[m].y})) * unpack4((u32x2){zw[m].x, zw[m].y}); y1 = (y1 + unpack4((u32x2){hfw[m].z, hfw[m].w})) * unpack4((u32x2){zw[m].z, zw[m].w}); }
                    const u32x2 p0 = pack4(y0), p1 = pack4(y1);
                    *(u32x4*)(BIG + (r * 2048u + 1024u + chb)) = (u32x4){p0.x, p0.y, p1.x, p1.y};
                }
                if constexpr (DIR == 1) { if (ai == 0) {
#pragma unroll
                    for (int m = 0; m < 4; ++m) { const unsigned r = row0 + 128 + m; hfw[m] = *(const u32x4*)(BIG + (r * 2048u + 1024u + chb)); zw[m] = *(const u32x4*)(SZB + (r * 1024u + chb)); } } }
            }
        }
        WG_BAR();
        return false;
    }
};

struct EpiC {
    const bf16_t* XC; const bf16_t* SZB; bf16_t* BIG;
    const float* br; const float* bi; const float* clam;
    u64* gran; unsigned epochF;
    LAS float* scr;
    __device__ __forceinline__ bool operator()(Acc& acc, const Unit& u, int wr, int wc, int fr, int fq) const {
        const int pm = u.pm, pn = u.pn;
        const int cl = 16 * wc + 4 * fq, ch0 = 64 * pn + cl;
        const unsigned row0 = (unsigned)pm * 256 + wr * 64 + fr;
        const f32x4 one4 = (f32x4){1.f, 1.f, 1.f, 1.f}, zero4 = (f32x4){0.f, 0.f, 0.f, 0.f};
        const int tq = (wr * 4 + wc) * 64 + fq * 16 + fr;
        constexpr int MODE = 1; const float cin = 0.f;
        u32x2 xw[2][4];
#pragma unroll
        for (int ai = 0; ai < 2; ++ai)
#pragma unroll
            for (int m = 0; m < 4; ++m) xw[ai][m] = *(const u32x2*)(XC + (size_t)(row0 + ai * 128 + m * 16) * 1024 + ch0);
        const float nl2e = opaque_f(-LOG2E), m1 = opaque_f(-1.0f);
#pragma unroll
        for (int d = 0; d < 2; ++d) {
            const f32x4 brv = *(const f32x4*)(br + d * 1024 + ch0) * (-LOG2E), biv = *(const f32x4*)(bi + d * 1024 + ch0) * (-LOG2E);
            const f32x4 cv = *(const f32x4*)(clam + d * 1024 + ch0) * LOG2E;
#pragma unroll
            for (int ai = 0; ai < 2; ++ai)
#pragma unroll
                for (int m = 0; m < 4; ++m) {
                    const f32x4 x = unpack4(xw[ai][m]);
                    const f32x4 tr = acc[ai][d][m][0] * nl2e + brv, ti = acc[ai][d][m][1] * nl2e + biv;
                    const f32x4 r = rcp4(exp2_4(tr) + 1.0f), pi = exp2_4(ti) + 1.0f;
                    const f32x4 a = exp2_4(cv * r);
                    const f32x4 w = (a * a) * m1 + 1.0f;
                    acc[ai][d][m][0] = a; acc[ai][d][m][1] = (w * rsq4((pi * pi) * w + 1e-30f)) * x;
                    __builtin_amdgcn_sched_barrier(0);
                }
        }
#define SCAN_STEP(SH) \
        "v_fmac_f32_dpp %0, %0, %4 " SH " row_mask:0xf bank_mask:0xf\n\tv_fmac_f32_dpp %1, %1, %5 " SH " row_mask:0xf bank_mask:0xf\n\t" \
        "v_fmac_f32_dpp %2, %2, %6 " SH " row_mask:0xf bank_mask:0xf\n\tv_fmac_f32_dpp %3, %3, %7 " SH " row_mask:0xf bank_mask:0xf\n\t" \
        "v_mul_f32_dpp %4, %4, %4 " SH " row_mask:0xf bank_mask:0xf\n\tv_mul_f32_dpp %5, %5, %5 " SH " row_mask:0xf bank_mask:0xf\n\t" \
        "v_mul_f32_dpp %6, %6, %6 " SH " row_mask:0xf bank_mask:0xf\n\tv_mul_f32_dpp %7, %7, %7 " SH " row_mask:0xf bank_mask:0xf\n\t"
#define SCAN_CARRY(BC) \
        "v_fmac_f32_dpp %0, %8, %4 " BC " row_mask:0xf bank_mask:0xf\n\tv_fmac_f32_dpp %1, %9, %5 " BC " row_mask:0xf bank_mask:0xf\n\t" \
        "v_fmac_f32_dpp %2, %10, %6 " BC " row_mask:0xf bank_mask:0xf\n\tv_fmac_f32_dpp %3, %11, %7 " BC " row_mask:0xf bank_mask:0xf\n\t" \
        "v_mul_f32_dpp %4, %12, %4 " BC " row_mask:0xf bank_mask:0xf\n\tv_mul_f32_dpp %5, %13, %5 " BC " row_mask:0xf bank_mask:0xf\n\t" \
        "v_mul_f32_dpp %6, %14, %6 " BC " row_mask:0xf bank_mask:0xf\n\tv_mul_f32_dpp %7, %15, %7 " BC " row_mask:0xf bank_mask:0xf\n\t"
#define SCAN_OUT(A, L) "+v"(L[0]), "+v"(L[1]), "+v"(L[2]), "+v"(L[3]), "+v"(A[0]), "+v"(A[1]), "+v"(A[2]), "+v"(A[3])
#define SCAN_IN(A, L) "v"(L[0]), "v"(L[1]), "v"(L[2]), "v"(L[3]), "v"(A[0]), "v"(A[1]), "v"(A[2]), "v"(A[3])
#pragma unroll
        for (int ai = 0; ai < 2; ++ai) {
            asm volatile("s_nop 1\n\t" SCAN_STEP("row_shr:1") SCAN_STEP("row_shr:2") SCAN_STEP("row_shr:4") SCAN_STEP("row_shr:8") "s_nop 1" : SCAN_OUT(acc[ai][0][0][0], acc[ai][0][0][1]));
#pragma unroll
            for (int m = 1; m < 4; ++m)
                asm volatile("s_nop 1\n\t" SCAN_STEP("row_shr:1") SCAN_STEP("row_shr:2") SCAN_STEP("row_shr:4") SCAN_STEP("row_shr:8") SCAN_CARRY("row_newbcast:15") "s_nop 1"
                             : SCAN_OUT(acc[ai][0][m][0], acc[ai][0][m][1]) : SCAN_IN(acc[ai][0][m - 1][0], acc[ai][0][m - 1][1]));
            asm volatile("s_nop 1\n\t" SCAN_STEP("row_shl:1") SCAN_STEP("row_shl:2") SCAN_STEP("row_shl:4") SCAN_STEP("row_shl:8") "s_nop 1" : SCAN_OUT(acc[ai][1][3][0], acc[ai][1][3][1]));
#pragma unroll
            for (int m = 2; m >= 0; --m)
                asm volatile("s_nop 1\n\t" SCAN_STEP("row_shl:1") SCAN_STEP("row_shl:2") SCAN_STEP("row_shl:4") SCAN_STEP("row_shl:8") SCAN_CARRY("row_newbcast:0") "s_nop 1"
                             : SCAN_OUT(acc[ai][1][m][0], acc[ai][1][m][1]) : SCAN_IN(acc[ai][1][m + 1][0], acc[ai][1][m + 1][1]));
            const int seg = 2 * ai + wr;
            if (fr == 15) {
#pragma unroll
                for (int j = 0; j < 4; ++j) *(LAS f32x2*)(scr + ((seg * 2 + 0) * 64 + cl + j) * 2) = (f32x2){acc[ai][0][3][0][j], acc[ai][0][3][1][j]};
            }
            if (fr == 0) {
#pragma unroll
                for (int j = 0; j < 4; ++j) *(LAS f32x2*)(scr + ((seg * 2 + 1) * 64 + cl + j) * 2) = (f32x2){acc[ai][1][0][0][j], acc[ai][1][0][1][j]};
            }
        }
#undef SCAN_STEP
#undef SCAN_CARRY
#undef SCAN_OUT
#undef SCAN_IN
        u32x2 zw[2][4];
        {
#pragma unroll
            for (int ai = 0; ai < 2; ++ai)
#pragma unroll
                for (int m = 0; m < 4; ++m) zw[ai][m] = *(const u32x2*)(SZB + (size_t)(row0 + ai * 128 + m * 16) * 1024 + ch0);
        }
        WG_BAR();
        {
            const int t = tq;
            LAS float* car = scr + 1024;
            if (t < 128) { const int d = t >> 6, c = t & 63;
                float h = cin;
#pragma unroll
                for (int s = 0; s < 4; ++s) { const int seg = d ? 3 - s : s; car[(seg * 2 + d) * 64 + c] = h; const f32x2 tb = *(const LAS f32x2*)(scr + ((seg * 2 + d) * 64 + c) * 2); h = tb.x * h + tb.y; }
                gr_store(gran + (d == 0 ? 2 * GR_N : 0) + (size_t)((pm - 64) * 8 + (pn >> 1)) * 128 + 64 * (pn & 1) + c, epochF + (unsigned)d, h);
            }
            {
                WG_BAR();
#pragma unroll
                for (int ai = 0; ai < 2; ++ai) {
                    const int seg = 2 * ai + wr;
                    const f32x4 hf = *(const LAS f32x4*)(car + (seg * 2 + 0) * 64 + cl), hb = *(const LAS f32x4*)(car + (seg * 2 + 1) * 64 + cl);
#pragma unroll
                    for (int m = 0; m < 4; ++m) {
                        const size_t r = row0 + ai * 128 + m * 16;
                        const f32x4 z = unpack4(zw[ai][m]);
                        const f32x4 y = (acc[ai][0][m][0] * hf + acc[ai][0][m][1]) + (acc[ai][1][m][0] * hb + acc[ai][1][m][1]);
                        *(u32x2*)(BIG + r * 2048 + 1024 + ch0) = pack4(y * z);
                    }
                }
            }
        }
        WG_BAR();
        return false;
    }
};

struct EpiG2 {
    const bf16_t* RAT; const bf16_t* SMB; bf16_t* MG; unsigned* cnt; unsigned* pcnt;
    __device__ __forceinline__ bool operator()(Acc& acc, const Unit& u, int wr, int wc, int fr, int fq) const {
        const unsigned row0 = (unsigned)u.pm * 256 + wr * 64 + fr; const unsigned col0 = 256 * u.pn + 32 * wc + 8 * fq;
        const bf16_t* src = u.kk == 0 ? RAT : SMB;
#pragma unroll
        for (int ai = 0; ai < 2; ++ai)
#pragma unroll
            for (int m = 0; m < 4; ++m) {
                if (m == 2) asm volatile("" ::: "memory");
#pragma unroll
                for (int bj = 0; bj < 2; ++bj) {
                    const unsigned off = (row0 + ai * 128 + m * 16) * 1024u + col0 + 128 * bj;
                    const u32x4 w = *(const u32x4*)(src + off);
                    acc[ai][bj][m][0] = acc[ai][bj][m][0] * unpack4((u32x2){w.x, w.y});
                    acc[ai][bj][m][1] = acc[ai][bj][m][1] * unpack4((u32x2){w.z, w.w});
                    if (u.kk == 1) { const u32x2 a = pack4(acc[ai][bj][m][0]), b = pack4(acc[ai][bj][m][1]); *(u32x4*)(MG + off) = (u32x4){a.x, a.y, b.x, b.y}; }
                }
            }
        unsigned* const pc = u.pm >= 64 ? cnt : (pcnt != nullptr ? pcnt + u.pm * 16 : nullptr);
        if (pc != nullptr && u.kk == 1) {
            asm volatile("s_waitcnt vmcnt(0)" ::: "memory"); WG_BAR();
            if (wr == 0 && wc == 0 && fq == 0 && fr == 0) { __builtin_amdgcn_fence(__ATOMIC_RELEASE, "agent"); asm volatile("s_waitcnt vmcnt(0)" ::: "memory");
                __hip_atomic_fetch_add(pc, 1u, __ATOMIC_RELAXED, __HIP_MEMORY_SCOPE_AGENT); }
        }
        return u.kk == 0;
    }
};

template <bool FINAL> struct EpiG3 {
    static constexpr bool AFTER_DRAIN = true;
    const float* xin_lat; const float* xin_ctx; float* out_lat; float* out_ctx; const float* mod;
    const float* gn; const float* modn;
    bf16_t* BIG; u64* xg; unsigned* tmo; unsigned epoch;
    LAS float* scr;
    unsigned* cnt;
    __device__ __forceinline__ void final(Acc& acc, const Unit& u, int wr, int wc, int lane, LAS unsigned char* lds) const {
        const int pm = u.pm; const bool isctx = pm >= 64; const int v = isctx ? 2 : (pm >> 5);
        const float* xin = isctx ? xin_ctx : xin_lat; float* out = isctx ? out_ctx : out_lat;
        const int fr = lane & 15, fq = lane >> 4, wave = wr * 4 + wc;
        const unsigned col = 256 * u.pn + 4 * lane;
        const unsigned rbase = (unsigned)(isctx ? pm - 64 : pm) * 256 + 16 * wave;
        const f32x4 gt = *(const f32x4*)(mod + v * 3072 + 2048 + col);
        f32x4 y[2][16]; float tot = 0.f;
#pragma unroll
        for (int h = 0; h < 2; ++h) {
#pragma unroll
            for (int bj = 0; bj < 2; ++bj)
#pragma unroll
                for (int m = 0; m < 4; ++m)
#pragma unroll
                    for (int n = 0; n < 2; ++n) { const int rowh = 64 * wr + 16 * m + fr, c16 = 32 * bj + 8 * wc + 4 * n + fq;
                        *(LAS f32x4*)(lds + rowh * 1024 + ((c16 ^ (rowh & 7)) << 4)) = acc[h][bj][m][n]; }
            WG_BAR();
#pragma unroll
            for (int rb = 0; rb < 4; ++rb) {
            f32x4 xv[4];
#pragma unroll
            for (int r8 = 0; r8 < 4; ++r8) { const float* rowp = xin + (size_t)(rbase + 128 * h + 4 * rb + r8) * 1024; xv[r8] = *(const f32x4*)(rowp + col); }
#pragma unroll
            for (int r8 = 0; r8 < 4; ++r8) { const int rr = 4 * rb + r8, rowh = 16 * wave + rr;
                const f32x4 a4 = *(const LAS f32x4*)(lds + rowh * 1024 + ((lane ^ (rowh & 7)) << 4));
                const f32x4 yy = xv[r8] + gt * a4; y[h][rr] = yy;
                if constexpr (!FINAL) { bf16_t* rowo = (bf16_t*)out + (size_t)(rbase + 128 * h + rr) * 2048; *(u32x2*)(rowo + col) = pack4(yy); }
                float ss = (yy[0] * yy[0] + yy[1] * yy[1]) + (yy[2] * yy[2] + yy[3] * yy[3]);
                ss += dppf<DPP_SHR(1)>(0.f, ss); ss += dppf<DPP_SHR(2)>(0.f, ss); ss += dppf<DPP_SHR(4)>(0.f, ss); ss += dppf<DPP_SHR(8)>(0.f, ss);
                const float rsum = (__builtin_bit_cast(float, __builtin_amdgcn_readlane(__builtin_bit_cast(int, ss), 15)) + __builtin_bit_cast(float, __builtin_amdgcn_readlane(__builtin_bit_cast(int, ss), 31)))
                                 + (__builtin_bit_cast(float, __builtin_amdgcn_readlane(__builtin_bit_cast(int, ss), 47)) + __builtin_bit_cast(float, __builtin_amdgcn_readlane(__builtin_bit_cast(int, ss), 63)));
                if (lane == 16 * h + rr) tot = rsum;
                if (r8 & 1) __builtin_amdgcn_sched_barrier(0); }
            asm volatile("" ::: "memory");
            }
            WG_BAR();
        }
        float rstd = 0.f;
        if (lane < 32) {
            const unsigned row = 128 * (lane >> 4) + 16 * wave + (lane & 15);
            u64* g = xg + ((size_t)pm * 256 + row) * 4;
            gr_store(g + u.pn, epoch, tot);
            u64 w[4]; unsigned spins = 0;
            for (;;) {
                bool ok = true;
#pragma unroll
                for (int t = 0; t < 4; ++t) { w[t] = gr_load(g + t); ok = ok && ((unsigned)(w[t] >> 32) == epoch); }
                if (ok) break;
                __builtin_amdgcn_s_sleep(2);
                if ((++spins & 63u) == 0u) { if (__hip_atomic_load(tmo, __ATOMIC_RELAXED, __HIP_MEMORY_SCOPE_AGENT) != 0u) break; if (spins > (1u << 16)) { __hip_atomic_store(tmo, 1u, __ATOMIC_RELAXED, __HIP_MEMORY_SCOPE_AGENT); break; } }
            }
            const float t4 = (__uint_as_float((unsigned)w[0]) + __uint_as_float((unsigned)w[1])) + (__uint_as_float((unsigned)w[2]) + __uint_as_float((unsigned)w[3]));
            rstd = rsqrtf(t4 * (1.0f / 1024.0f) + RMS_EPS);
        }
        f32x4 gs = *(const f32x4*)(gn + col), sh = (f32x4){0.f, 0.f, 0.f, 0.f};
        if constexpr (!FINAL) { gs = gs * (*(const f32x4*)(modn + v * 3072 + 1024 + col) + 1.0f); sh = *(const f32x4*)(modn + v * 3072 + col); }
        const unsigned hbase = (unsigned)pm * 256 + 16 * wave;
#pragma unroll
        for (int h = 0; h < 2; ++h)
#pragma unroll
            for (int rr = 0; rr < 16; ++rr) {
                const float rs = __builtin_bit_cast(float, __builtin_amdgcn_readlane(__builtin_bit_cast(int, rstd), 16 * h + rr));
                if constexpr (FINAL) { float* rowo = out + (size_t)(rbase + 128 * h + rr) * 1024; *(f32x4*)(rowo + col) = y[h][rr] * rs * gs; }
                else { bf16_t* rowh_ = BIG + (size_t)(hbase + 128 * h + rr) * 2048 + 1024; *(u32x2*)(rowh_ + col) = pack4(y[h][rr] * rs * gs + sh); }
            }
        if (cnt != nullptr && isctx) {
            asm volatile("s_waitcnt vmcnt(0)" ::: "memory"); WG_BAR();
            if (wave == 0 && lane == 0) { __builtin_amdgcn_fence(__ATOMIC_RELEASE, "agent"); asm volatile("s_waitcnt vmcnt(0)" ::: "memory");
                __hip_atomic_fetch_add(cnt, 1u, __ATOMIC_RELAXED, __HIP_MEMORY_SCOPE_AGENT); }
        }
    }
};

template <bool FINAL> struct EpiG3old {
    const float* xin_lat; const float* xin_ctx; float* out_lat; float* out_ctx; const float* mod;
    const float* gn; const float* modn;
    bf16_t* BIG; u64* xg; unsigned* tmo; unsigned epoch;
    LAS float* scr;
    unsigned* cnt;
    __device__ __forceinline__ bool operator()(Acc& acc, const Unit& u, int wr, int wc, int fr, int fq) const {
        const int pm = u.pm; const bool isctx = pm >= 64; const int v = isctx ? 2 : (pm >> 5);
        const float* xin = isctx ? xin_ctx : xin_lat; float* out = isctx ? out_ctx : out_lat;
        const size_t row0 = (size_t)(isctx ? pm - 64 : pm) * 256 + wr * 64 + fr; const int col0 = 256 * u.pn + 32 * wc + 4 * fq;
        const int tq = (wr * 4 + wc) * 64 + fq * 16 + fr, lane = fq * 16 + fr;
        {
            f32x4 gt[2][2];
#pragma unroll
            for (int bj = 0; bj < 2; ++bj)
#pragma unroll
                for (int n = 0; n < 2; ++n) gt[bj][n] = *(const f32x4*)(mod + v * 3072 + 2048 + col0 + 128 * bj + 16 * n);
#pragma unroll
            for (int ai = 0; ai < 2; ++ai)
#pragma unroll
                for (int m = 0; m < 4; ++m) {
                    float ss = 0.f;
#pragma unroll
                    for (int bj = 0; bj < 2; ++bj)
#pragma unroll
                        for (int n = 0; n < 2; ++n) { const size_t off = (row0 + ai * 128 + m * 16) * 1024 + col0 + 128 * bj + 16 * n;
                            f32x4 xr; if constexpr (FINAL) xr = unpack4(*(const u32x2*)((const bf16_t*)xin + off + (row0 + ai * 128 + m * 16) * 1024)); else xr = *(const f32x4*)(xin + off);
                            const f32x4 y = xr + gt[bj][n] * acc[ai][bj][m][n]; acc[ai][bj][m][n] = y;
                            if constexpr (!FINAL) *(f32x4*)(out + off) = y;
                            ss += (y[0] * y[0] + y[1] * y[1]) + (y[2] * y[2] + y[3] * y[3]); }
                    ss += __builtin_bit_cast(float, __builtin_amdgcn_ds_bpermute((lane ^ 16) << 2, __builtin_bit_cast(int, ss)));
                    ss += __builtin_bit_cast(float, __builtin_amdgcn_ds_bpermute((lane ^ 32) << 2, __builtin_bit_cast(int, ss)));
                    if (fq == 0) scr[(ai * 128 + wr * 64 + m * 16 + fr) * 4 + wc] = ss;
                    if (m & 1) asm volatile("" ::: "memory");
                }
        }
        WG_BAR();
        if (tq < 256) {
            const f32x4 p = *(const LAS f32x4*)(scr + tq * 4);
            u64* g = xg + ((size_t)pm * 256 + tq) * 4;
            gr_store(g + u.pn, epoch, (p[0] + p[1]) + (p[2] + p[3]));
            u64 w[4]; unsigned spins = 0;
            for (;;) {
                bool ok = true;
#pragma unroll
                for (int t = 0; t < 4; ++t) { w[t] = gr_load(g + t); ok = ok && ((unsigned)(w[t] >> 32) == epoch); }
                if (ok) break;
                __builtin_amdgcn_s_sleep(2);
                if ((++spins & 63u) == 0u) { if (__hip_atomic_load(tmo, __ATOMIC_RELAXED, __HIP_MEMORY_SCOPE_AGENT) != 0u) break; if (spins > (1u << 16)) { __hip_atomic_store(tmo, 1u, __ATOMIC_RELAXED, __HIP_MEMORY_SCOPE_AGENT); break; } }
            }
            const float tot = (__uint_as_float((unsigned)w[0]) + __uint_as_float((unsigned)w[1])) + (__uint_as_float((unsigned)w[2]) + __uint_as_float((unsigned)w[3]));
            scr[1024 + tq] = rsqrtf(tot * (1.0f / 1024.0f) + RMS_EPS);
        }
        WG_BAR();
        {
            f32x4 gs[2][2], sh[2][2];
#pragma unroll
            for (int bj = 0; bj < 2; ++bj)
#pragma unroll
                for (int n = 0; n < 2; ++n) { const int c = col0 + 128 * bj + 16 * n; gs[bj][n] = *(const f32x4*)(gn + c);
                    if constexpr (!FINAL) { gs[bj][n] = gs[bj][n] * (*(const f32x4*)(modn + v * 3072 + 1024 + c) + 1.0f); sh[bj][n] = *(const f32x4*)(modn + v * 3072 + c); } }
            const size_t hrow0 = (size_t)pm * 256 + wr * 64 + fr;
#pragma unroll
            for (int ai = 0; ai < 2; ++ai)
#pragma unroll
                for (int m = 0; m < 4; ++m) {
                    const float rstd = scr[1024 + ai * 128 + wr * 64 + m * 16 + fr];
#pragma unroll
                    for (int bj = 0; bj < 2; ++bj)
#pragma unroll
                        for (int n = 0; n < 2; ++n) { const int c = col0 + 128 * bj + 16 * n;
                            if constexpr (FINAL) *(f32x4*)(out + (row0 + ai * 128 + m * 16) * 1024 + c) = acc[ai][bj][m][n] * rstd * gs[bj][n];
                            else *(u32x2*)(BIG + (hrow0 + ai * 128 + m * 16) * 2048 + 1024 + c) = pack4(acc[ai][bj][m][n] * rstd * gs[bj][n] + sh[bj][n]); }
                }
        }
        if (cnt != nullptr && isctx) asm volatile("s_waitcnt vmcnt(0)" ::: "memory");
        WG_BAR();
        if (cnt != nullptr && isctx && tq == 0) { __builtin_amdgcn_fence(__ATOMIC_RELEASE, "agent"); asm volatile("s_waitcnt vmcnt(0)" ::: "memory");
            __hip_atomic_fetch_add(cnt, 1u, __ATOMIC_RELAXED, __HIP_MEMORY_SCOPE_AGENT); }
        return false;
    }
};

#define XB_TMO      128
#define XB_XCNT(j)  (256  + 64 * (j))
#define XB_XSUB(j)  (1280 + 64 * (j))
#define XB_XGEN(j)  (2304 + 64 * (j))
#define XB_TOP      3328
#define XB_TOPGEN   3392
#define XCD_BAR_WORDS 3456
#define XB_SPIN_CAP (1u << 18)
__device__ __forceinline__ unsigned xb_ld(unsigned* p)              { return __hip_atomic_load(p, __ATOMIC_RELAXED, __HIP_MEMORY_SCOPE_AGENT); }
__device__ __forceinline__ unsigned xb_add(unsigned* p, unsigned v) { return __hip_atomic_fetch_add(p, v, __ATOMIC_RELAXED, __HIP_MEMORY_SCOPE_AGENT); }
__device__ __forceinline__ unsigned xb_xcc_id() { return (unsigned)__builtin_amdgcn_s_getreg((3 << 11) | 20) & 0xFu; }
#define XB_SPIN(cond, bar) do { unsigned _sp = 0; while (cond) { __builtin_amdgcn_s_sleep(1); \
    if ((++_sp & 255u) == 0u) { if (xb_ld(&(bar)[XB_TMO])) break; if (_sp > XB_SPIN_CAP) { atomicAdd(&(bar)[XB_TMO], 1u); break; } } } } while (0)
struct XcdBarrier { unsigned* bar; unsigned x; volatile LAS unsigned* st; };
__device__ __forceinline__ XcdBarrier xcd_barrier_post(unsigned* bar, volatile LAS unsigned* st) {
    XcdBarrier b; b.bar = bar; b.x = xb_xcc_id(); b.st = st;
    if (threadIdx.x == 0) (void)xb_add(&bar[XB_XCNT(b.x)], 1u);
    return b;
}
__device__ __forceinline__ void xcd_barrier_complete(unsigned* bar, unsigned x, unsigned& nloc, unsigned& nx) {
    const unsigned G = gridDim.x * gridDim.y * gridDim.z;
    unsigned sum, cnt, mine, sp = 0u;
    for (;;) {
        sum = 0u; cnt = 0u; mine = 0u;
#pragma unroll
        for (unsigned j = 0; j < 16; ++j) { const unsigned c = xb_ld(&bar[XB_XCNT(j)]); sum += c; cnt += (c > 0u) ? 1u : 0u; mine = (j == x) ? c : mine; }
        if (sum == G) break;
        __builtin_amdgcn_s_sleep(1);
        if ((++sp & 255u) == 0u) { if (xb_ld(&bar[XB_TMO])) break; if (sp > XB_SPIN_CAP) { atomicAdd(&bar[XB_TMO], 1u); break; } }
    }
    nloc = mine > 0u ? mine : 1u; nx = cnt > 0u ? cnt : 1u;
}
__device__ __forceinline__ void xcd_barrier(const XcdBarrier& b, bool leader) {
    asm volatile("s_waitcnt vmcnt(0)" ::: "memory");
    __syncthreads();
    if (leader) {
        unsigned* bar = b.bar;
        __builtin_amdgcn_s_waitcnt(0);
        unsigned nloc = b.st[0], nx = b.st[1];
        if (nloc == 0u) { xcd_barrier_complete(bar, b.x, nloc, nx); b.st[0] = nloc; b.st[1] = nx; }
        const unsigned old = xb_add(&bar[XB_XSUB(b.x)], 1u);
        const unsigned gen = old / nloc;
        if (old + 1u == (gen + 1u) * nloc) {
            __builtin_amdgcn_fence(__ATOMIC_RELEASE, "agent");
            asm volatile("s_waitcnt vmcnt(0)" ::: "memory");
            const unsigned og = xb_add(&bar[XB_TOP], 1u);
            const unsigned tg = og / nx;
            if (og + 1u == (tg + 1u) * nx) xb_add(&bar[XB_TOPGEN], 1u);
            else XB_SPIN(xb_ld(&bar[XB_TOPGEN]) == tg, bar);
            __builtin_amdgcn_fence(__ATOMIC_ACQUIRE, "agent");
            xb_add(&bar[XB_XGEN(b.x)], 1u);
            asm volatile("s_waitcnt vmcnt(0)" ::: "memory");
        } else {
            XB_SPIN(xb_ld(&bar[XB_XGEN(b.x)]) == gen, bar);
            __builtin_amdgcn_fence(__ATOMIC_ACQUIRE, "agent");
            asm volatile("s_waitcnt vmcnt(0)" ::: "memory");
        }
    }
    __syncthreads();
}

struct Args { const float* in[20]; float* out; unsigned char* ws; int ph_lo, ph_hi; };
typedef __attribute__((address_space(4))) const Args CArgs;
struct InTab { CArgs* ka; __device__ __forceinline__ const float* operator[](int i) const { return ka->in[i]; } };
struct Frame {
    LAS unsigned char* lds; int tid, lane, wave, vcu, G, bx;
    InTab in; float* out; unsigned char* ws;
    __device__ __forceinline__ void ids() { const int l = fresh_lane(); lane = l; tid = wave * 64 + l; }
};
__device__ __forceinline__ int opaque_v(int x) { asm volatile("" : "+v"(x)); return x; }
__device__ __forceinline__ unsigned opaque_s(unsigned x) { asm volatile("" : "+s"(x)); return x; }
__device__ __forceinline__ float wave_sum(float v, int lane) {
#pragma unroll
    for (int o = 1; o < 64; o <<= 1) v += __builtin_bit_cast(float, __builtin_amdgcn_ds_bpermute((lane ^ o) << 2, __builtin_bit_cast(int, v)));
    return v;
}

__device__ __forceinline__ int w1_dest_row(int s) {
    const int chunk = s >> 10, ch = s & 1023;
    if (chunk < 4) { const int g = chunk == 0 ? 0 : (chunk == 1 ? 2 : (chunk == 2 ? 1 : 3)); return 256 * (ch >> 6) + 128 * (g >> 1) + 32 * ((ch >> 4) & 3) + 16 * (g & 1) + (ch & 15); }
    if (chunk < 6) { const int pn = (chunk == 4 ? 16 : 20) + (ch >> 8), r = ch & 255; return 256 * pn + 128 * (r >> 7) + 32 * ((r >> 5) & 3) + 16 * ((r >> 2) & 1) + 4 * ((r >> 3) & 3) + (r & 3); }
    { const int pn = 24 + (ch >> 7), r = ch & 127; return 256 * pn + 128 * (chunk - 6) + 32 * (r >> 5) + 16 * ((r >> 2) & 1) + 4 * ((r >> 3) & 3) + (r & 3); }
}
__device__ __forceinline__ int perm8_dest_row(int o) { return (o & ~31) | (((o >> 2) & 1) << 4) | (((o >> 3) & 3) << 2) | (o & 3); }
template <int MODE> __device__ __forceinline__ void tr_item(const float* W, int ldsrc, int k0, int n0, bf16_t* dst, int lddst, int dcol0, int p0, LAS float* scr, int lane) {
#pragma unroll 8
    for (int i = 0; i < 32; ++i) { const int kk = 2 * i + (lane >> 5); scr[kk * 33 + (lane & 31)] = W[(size_t)(k0 + kk) * ldsrc + n0 + (lane & 31)]; }
    LDS_WAIT(); asm volatile("" ::: "memory");
    const int c = lane & 7;
#pragma unroll
    for (int j = 0; j < 4; ++j) { const int n = (lane >> 3) + 8 * j; const LAS float* s = scr + (8 * c) * 33 + n;
        u32x4 o; o.x = cvt_pk_bf16(s[0 * 33], s[1 * 33]); o.y = cvt_pk_bf16(s[2 * 33], s[3 * 33]); o.z = cvt_pk_bf16(s[4 * 33], s[5 * 33]); o.w = cvt_pk_bf16(s[6 * 33], s[7 * 33]);
        const int sn = n0 + n; int drow;
        if (MODE == 0) drow = w1_dest_row(sn);
        else if (MODE == 1) drow = perm8_dest_row(sn);
        else if (MODE == 2) drow = sn;
        else if (MODE == 3) drow = p0 + 32 * (sn >> 5) + 16 * ((sn >> 2) & 1) + 4 * ((sn >> 3) & 3) + (sn & 3);
        else drow = p0 + 256 * (sn >> 6) + 32 * ((sn >> 4) & 3) + (sn & 15);
        *(u32x4*)(dst + (size_t)drow * lddst + dcol0 + k0 + 8 * c) = o; }
    LDS_WAIT(); asm volatile("" ::: "memory");
}
__device__ __forceinline__ void convert_layer(Frame& F, int l, int gw, int nw) {
    F.ids();
    LAS float* scr = (LAS float*)(F.lds + F.wave * 16384);
    for (int it = gw; it < 4096 + 1536 + 512; it += nw) {
        if (it < 4096) { const int kb = it >> 8, nb = it & 255;
            tr_item<0>(F.in[7] + (size_t)l * 1024 * 8192, 8192, 64 * kb, 32 * nb, (bf16_t*)(F.ws + WS_W1T) + (size_t)l * 8192 * 1024, 1024, 0, 0, scr, F.lane); }
        else if (it < 4096 + 1536) { int r = it - 4096; const int which = r / 512; r %= 512; const int kb = r >> 5, nb = r & 31;
            if (which == 0) tr_item<1>(F.in[16] + (size_t)l * 1024 * 1024, 1024, 64 * kb, 32 * nb, (bf16_t*)(F.ws + WS_WABT) + (size_t)l * 1024 * 2048, 2048, 0, 0, scr, F.lane);
            else if (which == 1) tr_item<1>(F.in[17] + (size_t)l * 1024 * 1024, 1024, 64 * kb, 32 * nb, (bf16_t*)(F.ws + WS_WABT) + (size_t)l * 1024 * 2048, 2048, 1024, 0, scr, F.lane);
            else tr_item<2>(F.in[18] + (size_t)l * 1024 * 1024, 1024, 64 * kb, 32 * nb, (bf16_t*)(F.ws + WS_WOT) + (size_t)l * 1024 * 1024, 1024, 0, 0, scr, F.lane); }
        else { int r = it - 4096 - 1536; const bool ctxl = r >= 256; if (ctxl) r -= 256; const int mat = r >> 3; r &= 7; const int kb = r >> 2, nb = r & 3; const int dir = (mat >> 4) & 1, isI = (mat >> 3) & 1, blk = mat & 7;
            const float* W = (isI ? F.in[13] : F.in[11]) + (size_t)((l * 2 + dir) * 8 + blk) * 128 * 128;
            if (!ctxl) tr_item<3>(W, 128, 64 * kb, 32 * nb, (bf16_t*)(F.ws + WS_GWT) + (size_t)l * 4096 * 128, 128, 0, (dir * 8 + blk) * 256 + 128 * isI, scr, F.lane);
            else tr_item<4>(W, 128, 64 * kb, 32 * nb, (bf16_t*)(F.ws + WS_GWTC) + (size_t)l * 4096 * 128, 128, 0, 512 * blk + 128 * dir + 16 * isI, scr, F.lane); }
    }
}
__device__ __forceinline__ void p0_prologue(Frame& F) {
    F.ids();
    const float* c = F.in[1]; const float* c_ctx = F.in[3]; const float* w_ada = F.in[4]; const float* b_ada = F.in[5];
    float* MOD = (float*)(F.ws + WS_MOD);
    if (F.bx < 192) {
        LAS float* sc = (LAS float*)F.lds;
        LAS float* red = sc + 3072;
        for (int i = F.tid; i < 3072; i += 512) { const float x = i < 2048 ? c[i] : c_ctx[i - 2048]; sc[i] = x * sigmoidf_(x); }
        __syncthreads();
        for (int u = F.bx; u < 192; u += F.G) {
            const int l = u / 96, cl = F.lane & 31, col = (u % 96) * 32 + cl, k0 = F.wave * 128 + (F.lane >> 5);
            const float* W = w_ada + (size_t)l * 1024 * 3072 + col;
            float a0 = 0.f, a1 = 0.f, a2 = 0.f;
#pragma unroll 16
            for (int kk = 0; kk < 64; ++kk) { const int k = k0 + 2 * kk; const float w = W[(size_t)k * 3072]; a0 += sc[k] * w; a1 += sc[1024 + k] * w; a2 += sc[2048 + k] * w; }
            a0 += __builtin_bit_cast(float, __builtin_amdgcn_ds_bpermute((F.lane ^ 32) << 2, __builtin_bit_cast(int, a0)));
            a1 += __builtin_bit_cast(float, __builtin_amdgcn_ds_bpermute((F.lane ^ 32) << 2, __builtin_bit_cast(int, a1)));
            a2 += __builtin_bit_cast(float, __builtin_amdgcn_ds_bpermute((F.lane ^ 32) << 2, __builtin_bit_cast(int, a2)));
            if (F.lane < 32) { red[(F.wave * 3 + 0) * 32 + cl] = a0; red[(F.wave * 3 + 1) * 32 + cl] = a1; red[(F.wave * 3 + 2) * 32 + cl] = a2; }
            __syncthreads();
            if (F.tid < 96) { const int v = F.tid >> 5, c2 = F.tid & 31; float s = 0.f;
#pragma unroll
                for (int w = 0; w < 8; ++w) s += red[(w * 3 + v) * 32 + c2];
                const int colo = (u % 96) * 32 + c2; MOD[(l * 3 + v) * 3072 + colo] = s + b_ada[l * 3072 + colo]; }
            __syncthreads();
        }
    }
    __syncthreads();
    { const int gi = F.bx * 512 + F.tid; if (gi < NL * 2 * 1024) { const float e = __builtin_amdgcn_exp2f(-F.in[15][gi] * LOG2E);
            ((float*)(F.ws + WS_CLAM))[gi] = -8.0f * (e * (1.0f + e * (-0.5f + e * (0.33333334f + e * (-0.25f + e * 0.2f))))); } }
    convert_layer(F, 0, F.vcu * NWAVES + F.wave, F.G * NWAVES);
}

__device__ __forceinline__ void norm_phase(Frame& F, int l, bool final) {
    F.ids();
    const int gw = F.vcu * NWAVES + F.wave, NGW = F.G * NWAVES;
    const float* MOD = (const float*)(F.ws + WS_MOD) + (size_t)l * 3 * 3072;
    const float* gsrc = final ? F.in[19] : F.in[6] + l * 1024;
    bf16_t* BIG = (bf16_t*)(F.ws + WS_BIG);
    const int nrows = final ? ML : M;
    f32x4 g4[4];
#pragma unroll
    for (int j = 0; j < 4; ++j) g4[j] = *(const f32x4*)(gsrc + 4 * F.lane + 256 * j);
    for (int row = gw; row < nrows; row += NGW) {
        const bool isctx = row >= ML;
        const float* src = (l == 0 && !final) ? (isctx ? F.in[2] + (size_t)(row - ML) * 1024 : F.in[0] + (size_t)row * 1024)
                                              : (isctx ? (const float*)(F.ws + WS_CTX1) + (size_t)(row - ML) * 1024 : F.out + (size_t)row * 1024);
        f32x4 v[4]; float ss = 0.f;
#pragma unroll
        for (int j = 0; j < 4; ++j) { v[j] = *(const f32x4*)(src + 4 * F.lane + 256 * j); ss += (v[j][0] * v[j][0] + v[j][1] * v[j][1]) + (v[j][2] * v[j][2] + v[j][3] * v[j][3]); }
        const float rstd = rsqrtf(wave_sum(ss, F.lane) * (1.0f / 1024.0f) + RMS_EPS);
        if (final) {
#pragma unroll
            for (int j = 0; j < 4; ++j) *(f32x4*)(F.out + (size_t)row * 1024 + 4 * F.lane + 256 * j) = v[j] * rstd * g4[j];
        } else {
            const int vi = isctx ? 2 : (row >> 13);
            const float* sh = MOD + vi * 3072; const float* scl = sh + 1024;
#pragma unroll
            for (int j = 0; j < 4; ++j) { const int cidx = 4 * F.lane + 256 * j;
                const f32x4 y = v[j] * rstd * g4[j]; const f32x4 h = y * (*(const f32x4*)(scl + cidx) + 1.0f) + *(const f32x4*)(sh + cidx);
                *(u32x2*)(BIG + (size_t)row * 2048 + 1024 + cidx) = pack4(h); }
        }
    }
}

__device__ __forceinline__ void panel_wait(const pg8::Sched& S, unsigned* pc, int wave) {
    asm volatile("" : "+s"(wave));
    if (wave == 0) {
        pg8::Unit u0;
        for (int i = 0; S.next(i, u0); ++i) { unsigned spins = 0;
            while (__hip_atomic_load(pc + u0.pm * 16, __ATOMIC_RELAXED, __HIP_MEMORY_SCOPE_AGENT) < 4u) { __builtin_amdgcn_s_sleep(2); if (++spins > (1u << 20)) break; } }
        __builtin_amdgcn_fence(__ATOMIC_ACQUIRE, "agent"); asm volatile("s_waitcnt vmcnt(0)" ::: "memory");
    }
    __syncthreads();
}

constexpr int N_PHASES = 12;
__global__ void __launch_bounds__(NWAVES * 64, 2) mk_fwd(Args args) {
    extern __shared__ __attribute__((aligned(16))) unsigned char lds[];
    const int wave_id = __builtin_amdgcn_readfirstlane((int)threadIdx.x >> 6);
    volatile LAS unsigned* MISC = (volatile LAS unsigned*)((LAS unsigned char*)lds + MISC_OFF);
    for (int u = threadIdx.x; u < 128; u += NWAVES * 64) MISC[u] = 0u;
    __syncthreads();
    XcdBarrier bar; bar.bar = (unsigned*)(args.ws + WS_CTL) + CW_BAR; bar.x = 0; bar.st = nullptr;
    if (!MK_PER_PHASE) bar = xcd_barrier_post((unsigned*)(args.ws + WS_CTL) + CW_BAR, MISC + 8);

    for (int it = 2 * args.ph_lo; it < 2 * args.ph_hi; ++it) {
        const int ph = it >> 1;
        if (it & 1) {
            const int kind = ph == 0 ? 7 : (ph == 1 ? 0 : 1 + (ph - 2) % 5);
            if (!((DUP_MASK >> kind) & 1) || kind == 5 || kind == 3) continue;
        }
        CArgs* ka = (CArgs*)__builtin_amdgcn_kernarg_segment_ptr(); asm volatile("" : "+s"(ka));
        Frame F;
        F.lds = (LAS unsigned char*)lds;
        F.wave = wave_id; F.lane = 0; F.tid = 0;
        int bx_ = blockIdx.x, G_ = gridDim.x; asm volatile("" : "+s"(bx_), "+s"(G_));
        F.G = G_; F.bx = bx_; F.vcu = (F.G % 8 == 0) ? (bx_ % 8) * (F.G / 8) + bx_ / 8 : bx_;
        F.in.ka = ka; F.out = ka->out; F.ws = ka->ws;
        LAS float* scr = (LAS float*)(F.lds + SCR_OFF);
        bf16_t* BIG = (bf16_t*)(F.ws + WS_BIG); bf16_t* XC = (bf16_t*)(F.ws + WS_XC); bf16_t* SZB = (bf16_t*)(F.ws + WS_SZB); bf16_t* RAT = (bf16_t*)(F.ws + WS_RAT); bf16_t* SMB = (bf16_t*)(F.ws + WS_SMB);
        float* CTX1 = (float*)(F.ws + WS_CTX1);
        if (ph == 0) { p0_prologue(F); }
        else if (ph == 1) { norm_phase(F, 0, false); }
        else {
            const int l = (ph - 2) / 5, sub = 1 + (ph - 2) % 5;
            if (sub == 1) {
                pg8::Gemm g{BIG + 1024, (const bf16_t*)(F.ws + WS_W1T) + (size_t)l * 8192 * 1024, 2048, 1024, 1024, 0, 0, 0, 0, 1};
                unsigned* ctxcnt = (unsigned*)(F.ws + WS_CTL) + CW_CTXCNT + 64 * l;
                if (l == 1 && F.bx < 8) {
                    unsigned* c2 = (unsigned*)(F.ws + WS_CTL) + CW_CG2CNT; unsigned* c3 = (unsigned*)(F.ws + WS_CTL) + CW_CG3CNT;
                    const float* MODp = (const float*)(F.ws + WS_MOD);
                    {   pg8::Gemm ga{BIG, (const bf16_t*)(F.ws + WS_WABT), 2048, 2048, 1024, 1024, 1024, 0, 0};
                        pg8::Sched Sa; Sa.init(0, 4, F.G, F.bx, 2, 8, 64, 0, 4); Sa.list_off = 0;
                        EpiG2 Ea{RAT, SMB, XC, c2, nullptr};
                        pg8::gemm_phase<EpiG2>(F.lds, ga, Sa, Ea, F.wave); }
                    if (F.wave == 0) { unsigned spins = 0; while (__hip_atomic_load(c2, __ATOMIC_RELAXED, __HIP_MEMORY_SCOPE_AGENT) < 8u) { __builtin_amdgcn_s_sleep(4); if (++spins > (1u << 20)) break; }
                        __builtin_amdgcn_fence(__ATOMIC_ACQUIRE, "agent"); asm volatile("s_waitcnt vmcnt(0)" ::: "memory"); }
                    __syncthreads();
                    {   pg8::Gemm gb{XC, (const bf16_t*)(F.ws + WS_WOT), 1024, 1024, 1024, 0, 0, 0, 0};
                        pg8::Sched Sb; Sb.init(0, 4, F.G, F.bx, 1, 8, 64, 0, 4); Sb.list_off = 0;
                        EpiG3old<false> Eb{F.in[0], F.in[2], F.out, CTX1, MODp, F.in[6] + 1024, MODp + 3 * 3072, BIG, (u64*)(F.ws + WS_GRAN) + 3 * GR_N, (unsigned*)(F.ws + WS_CTL) + CW_PTMO, opaque_s(1u), scr, c3};
                        pg8::gemm_phase<EpiG3old<false>>(F.lds, gb, Sb, Eb, F.wave); }
                    if (F.wave == 0) { unsigned spins = 0; while (__hip_atomic_load(c3, __ATOMIC_RELAXED, __HIP_MEMORY_SCOPE_AGENT) < 8u) { __builtin_amdgcn_s_sleep(4); if (++spins > (1u << 20)) break; }
                        __builtin_amdgcn_fence(__ATOMIC_ACQUIRE, "agent"); asm volatile("s_waitcnt vmcnt(0)" ::: "memory"); }
                    __syncthreads();
                }
                {
                    pg8::Sched S; if (l == 0) { S.init(64, 32, F.G, F.bx, 1, 64, 64, 0, 32); S.extra_first = 1; } else { S.init(64, 32, F.G, F.bx); S.late_n = 8; S.late_r = 7; }
                    EpiG1 E{BIG, XC, SZB, RAT, SMB, F.in[8] + l * 3 * 1024, F.in[9] + l * 4 * 1024, F.in[10] + l * 1024, scr, ctxcnt};
                    pg8::gemm_phase<EpiG1>(F.lds, g, S, E, F.wave);
                }
                {
                    pg8::Sched S2; S2.init(0, 1, F.G, F.bx, 1, 32, 64, 0, 16); S2.list_off = 64 % F.G;
                    pg8::Unit u0;
                    if (S2.next(0, u0) || S2.next(1, u0)) {
                        if (F.wave == 0) {
                            const unsigned want = l == 0 ? 64u : 8u; unsigned spins = 0;
                            while (__hip_atomic_load(ctxcnt, __ATOMIC_RELAXED, __HIP_MEMORY_SCOPE_AGENT) < want) { __builtin_amdgcn_s_sleep(4); if (++spins > (1u << 20)) break; }
                            __builtin_amdgcn_fence(__ATOMIC_ACQUIRE, "agent"); asm volatile("s_waitcnt vmcnt(0)" ::: "memory");
                        }
                        __syncthreads();
                        pg8::Gemm g2{XC, (const bf16_t*)(F.ws + WS_GWTC) + (size_t)l * 4096 * 128, 1024, 128, 128, 0, 0, 1, 128};
                        EpiC E2{XC, SZB, BIG, F.in[12] + l * 2048, F.in[14] + l * 2048, (const float*)(F.ws + WS_CLAM) + l * 2048, (u64*)(F.ws + WS_GRAN), (unsigned)(l * 2 + 1), scr};
                        pg8::gemm_phase<EpiC>(F.lds, g2, S2, E2, F.wave);
                    }
                }
                if (l == 0) {
                    const int first = F.G > 96 ? 96 : 0;
                    if (F.bx >= first) { __syncthreads(); convert_layer(F, 1, (F.bx - first) * NWAVES + F.wave, (F.G - first) * NWAVES); }
                }
            } else if (sub == 2 || sub == 3) {
                const int dir = sub - 2;
                pg8::Gemm g{XC, (const bf16_t*)(F.ws + WS_GWT) + (size_t)l * 4096 * 128 + (size_t)dir * 2048 * 128, 1024, 128, 128, 0, 0, 0, 128};
                pg8::Sched S; S.init_pass(F.G, F.bx, dir);
                unsigned* tmo = (unsigned*)(F.ws + WS_CTL) + CW_PTMO;
                if (dir == 0) { EpiP<0> E{XC, SZB, BIG, F.in[12] + l * 2048, F.in[14] + l * 2048, (const float*)(F.ws + WS_CLAM) + l * 2048, (u64*)(F.ws + WS_GRAN), tmo, (unsigned)(l * 2 + 1), scr, F.lds};
                    pg8::pass_phase<EpiP<0>>(F.lds, g, S, E, F.wave); }
                else { EpiP<1> E{XC, SZB, BIG, F.in[12] + l * 2048 + 1024, F.in[14] + l * 2048 + 1024, (const float*)(F.ws + WS_CLAM) + l * 2048 + 1024, (u64*)(F.ws + WS_GRAN), tmo, (unsigned)(l * 2 + 2), scr, F.lds};
                    pg8::pass_phase<EpiP<1>>(F.lds, g, S, E, F.wave); }
            }
            else if (sub == 4) {
                pg8::Gemm g{BIG, (const bf16_t*)(F.ws + WS_WABT) + (size_t)l * 1024 * 2048, 2048, 2048, 1024, 1024, 1024, 0, 0};
                pg8::Sched S; S.init(64, 4, F.G, F.bx, 2); S.wgm = WGM_G23;
                EpiG2 E{RAT, SMB, XC, nullptr, (unsigned*)(F.ws + WS_CTL) + CW_PANCNT + l * 1024};
                pg8::gemm_phase<EpiG2>(F.lds, g, S, E, F.wave);
            } else {
                pg8::Gemm g{XC, (const bf16_t*)(F.ws + WS_WOT) + (size_t)l * 1024 * 1024, 1024, 1024, 1024, 0, 0, 0, 0};
                unsigned* tmo = (unsigned*)(F.ws + WS_CTL) + CW_PTMO; u64* xg = (u64*)(F.ws + WS_GRAN) + 3 * GR_N;
                const float* MODp = (const float*)(F.ws + WS_MOD);
                if (l == 0) {
                    EpiG3<false> E{F.in[0], F.in[2], F.out, CTX1, MODp, F.in[6] + 1024, MODp + 3 * 3072, BIG, xg, tmo, opaque_s(1u), scr, nullptr};
                    pg8::Sched S; S.init(64, 4, F.G, F.bx); S.wgm = WGM_G23;
                    panel_wait(S, (unsigned*)(F.ws + WS_CTL) + CW_PANCNT + l * 1024, F.wave);
                    pg8::gemm_phase<EpiG3<false>>(F.lds, g, S, E, F.wave);
                } else {
                    EpiG3old<true> E{F.out, CTX1, F.out, CTX1, MODp + 3 * 3072, F.in[19], MODp, BIG, xg, tmo, opaque_s(2u), scr, nullptr};
                    pg8::Sched S; S.init(64, 4, F.G, F.bx); S.wgm = WGM_G23;
                    panel_wait(S, (unsigned*)(F.ws + WS_CTL) + CW_PANCNT + l * 1024, F.wave);
                    pg8::gemm_phase<EpiG3old<true>>(F.lds, g, S, E, F.wave);
                }
            }
        }
        if (it < 2 * args.ph_hi - 2 && !(ph >= 2 && (ph - 2) % 5 == 3 && !MK_PER_PHASE)) { const int ln2 = fresh_lane(); xcd_barrier(bar, wave_id == 0 && ln2 == 0); }
#if EXTRA_BARS
        if (ph == 4) { for (int eb = 0; eb < EXTRA_BARS; ++eb) { const int ln3 = fresh_lane(); xcd_barrier(bar, wave_id == 0 && ln3 == 0); } }
#endif
    }
}

extern "C" void kernel_launch(void* const* d_in, const int* in_sizes, int n_in, void* d_out, int out_size, void* d_ws, size_t ws_size, hipStream_t stream) {
    static int grid = 0;
    if (grid == 0) {
        if (n_in != 20 || in_sizes[0] != ML * D || out_size != ML * D || ws_size < WS_END) {
            fprintf(stderr, "kernel_launch: unexpected shapes: n_in %d in0 %d out %d ws %zu (need %zu)\n", n_in, n_in > 0 ? in_sizes[0] : -1, out_size, ws_size, (size_t)WS_END); grid = -1; return; }
        int dev = 0, cus = 0, per_cu = 0;
        if (hipGetDevice(&dev) != hipSuccess || hipDeviceGetAttribute(&cus, hipDeviceAttributeMultiprocessorCount, dev) != hipSuccess) { grid = -1; return; }
        if (hipFuncSetAttribute((const void*)mk_fwd, hipFuncAttributeMaxDynamicSharedMemorySize, LDS_BYTES) != hipSuccess) { fprintf(stderr, "kernel_launch: hipFuncSetAttribute failed\n"); grid = -1; return; }
        if (hipOccupancyMaxActiveBlocksPerMultiprocessor(&per_cu, (const void*)mk_fwd, NWAVES * 64, LDS_BYTES) != hipSuccess || per_cu < 1) {
            fprintf(stderr, "kernel_launch: occupancy query reports %d workgroups per CU\n", per_cu); (void)hipGetLastError(); grid = -1; return; }
        grid = cus < 256 ? cus : 256;
    }
    if (grid < 0) return;
    if (hipMemsetAsync((char*)d_ws + WS_CTL, 0, CTL_ZERO_BYTES, stream) != hipSuccess) return;
    Args a{};
    for (int i = 0; i < 20; ++i) a.in[i] = (const float*)d_in[i];
    a.out = (float*)d_out; a.ws = (unsigned char*)d_ws;
#if MK_PER_PHASE
    for (int ph = 0; ph < N_PHASES; ++ph) { a.ph_lo = ph; a.ph_hi = ph + 1; hipLaunchKernelGGL(mk_fwd, dim3(grid), dim3(NWAVES * 64), LDS_BYTES, stream, a); }
#else
    a.ph_lo = 0; a.ph_hi = N_PHASES;
    hipLaunchKernelGGL(mk_fwd, dim3(grid), dim3(NWAVES * 64), LDS_BYTES, stream, a);
#endif
    const hipError_t le = hipPeekAtLastError();
    if (le != hipSuccess) fprintf(stderr, "kernel_launch: launch failed: %s\n", hipGetErrorName(le));
}
```

```cpp
#include <hip/hip_runtime.h>
#include <cstdio>
#include <cstdint>

#ifndef MK_PER_PHASE
#define MK_PER_PHASE 0
#endif

#ifndef EXTRA_BARS
#define EXTRA_BARS 0
#endif
#ifndef DUP_MASK
#define DUP_MASK 0
#endif

#define LAS __attribute__((address_space(3)))
#define GAS __attribute__((address_space(1)))
typedef unsigned short bf16_t;
typedef short bf16x8 __attribute__((ext_vector_type(8)));
typedef float f32x4 __attribute__((ext_vector_type(4)));
typedef float f32x2 __attribute__((ext_vector_type(2)));
typedef unsigned u32x4 __attribute__((ext_vector_type(4)));
typedef unsigned u32x2 __attribute__((ext_vector_type(2)));
typedef GAS unsigned gu32;

constexpr int D = 1024, NB = 2, T = 8192, CT = 256, NL = 2, DIN = 8192;
constexpr int ML = NB * T;
constexpr int MC = NB * CT;
constexpr int M = ML + MC;
constexpr float RMS_EPS = 1e-6f;
constexpr float LOG2E = 1.4426950408889634f;

constexpr size_t MiB = 1u << 20;
constexpr size_t WS_CTL = 0, CTL_ZERO_BYTES = 4 * MiB;
constexpr size_t WS_MOD = 1 * MiB;
constexpr size_t WS_CLAM = WS_MOD + 128 * 1024;
constexpr size_t WS_CTX1 = 4 * MiB;
constexpr size_t WS_W1T = 6 * MiB;
constexpr size_t WS_WABT = 38 * MiB;
constexpr size_t WS_WOT = 46 * MiB;
constexpr size_t WS_GWT = 50 * MiB;
constexpr size_t WS_BIG = 52 * MiB;
constexpr size_t WS_XC = 118 * MiB;
constexpr size_t WS_SZB = 151 * MiB;
constexpr size_t WS_RAT = 184 * MiB;
constexpr size_t WS_SMB = 217 * MiB;
constexpr size_t WS_GRAN = 1 * MiB + 512 * 1024;
constexpr size_t GRAN_BYTES = 2 * MiB + 256 * 1024;
constexpr size_t WS_GWTC = 253 * MiB;
constexpr size_t WS_END = 255 * MiB;
static_assert(WS_CLAM + NL * 2 * 1024 * 4 <= WS_GRAN && WS_GRAN + GRAN_BYTES <= WS_CTX1 && (size_t)(3 * 33 * 16 * 128 + 66 * 256 * 4) * 8 <= GRAN_BYTES && WS_CTX1 >= CTL_ZERO_BYTES, "ws map");
static_assert((size_t)M * 1024 * 2 == 33 * MiB, "ws map");

constexpr int CW_BAR = 4096;
constexpr int CW_CG2CNT = 320, CW_CG3CNT = 384;
constexpr int CW_CTXCNT = 192;
constexpr int CW_PANCNT = 8192;
constexpr int CW_PTMO = 64;
constexpr int GR_N = 33 * 16 * 128;

constexpr int RING_BYTES = 131072;
constexpr int MISC_OFF = RING_BYTES;
constexpr int SCR_OFF = RING_BYTES + 512;
constexpr int LDS_BYTES = 147456;
constexpr int NWAVES = 8;

__device__ __forceinline__ unsigned cvt_pk_bf16(float lo, float hi) { unsigned r; asm volatile("v_cvt_pk_bf16_f32 %0, %1, %2" : "=v"(r) : "v"(lo), "v"(hi)); return r; }
__device__ __forceinline__ float bf_lo(unsigned w) { return __uint_as_float(w << 16); }
__device__ __forceinline__ float bf_hi(unsigned w) { return __uint_as_float(w & 0xffff0000u); }
__device__ __forceinline__ f32x4 unpack4(u32x2 w) { return (f32x4){bf_lo(w.x), bf_hi(w.x), bf_lo(w.y), bf_hi(w.y)}; }
__device__ __forceinline__ u32x2 pack4(f32x4 v) { u32x2 w; w.x = cvt_pk_bf16(v[0], v[1]); w.y = cvt_pk_bf16(v[2], v[3]); return w; }
__device__ __forceinline__ float sigmoidf_(float x) { return __builtin_amdgcn_rcpf(1.0f + __builtin_amdgcn_exp2f(-x * LOG2E)); }
__device__ __forceinline__ f32x4 exp2_4(f32x4 t) { return (f32x4){__builtin_amdgcn_exp2f(t[0]), __builtin_amdgcn_exp2f(t[1]), __builtin_amdgcn_exp2f(t[2]), __builtin_amdgcn_exp2f(t[3])}; }
__device__ __forceinline__ f32x4 rcp4(f32x4 t) { return (f32x4){__builtin_amdgcn_rcpf(t[0]), __builtin_amdgcn_rcpf(t[1]), __builtin_amdgcn_rcpf(t[2]), __builtin_amdgcn_rcpf(t[3])}; }
__device__ __forceinline__ f32x4 rsq4(f32x4 t) { return (f32x4){__builtin_amdgcn_rsqf(t[0]), __builtin_amdgcn_rsqf(t[1]), __builtin_amdgcn_rsqf(t[2]), __builtin_amdgcn_rsqf(t[3])}; }
__device__ __forceinline__ f32x4 sqrt4(f32x4 t) { return (f32x4){__builtin_amdgcn_sqrtf(t[0]), __builtin_amdgcn_sqrtf(t[1]), __builtin_amdgcn_sqrtf(t[2]), __builtin_amdgcn_sqrtf(t[3])}; }
__device__ __forceinline__ float opaque_f(float x) { asm("" : "+s"(x)); return x; }
__device__ __forceinline__ f32x4 sigmoid4(f32x4 x) { return rcp4(exp2_4(x * opaque_f(-LOG2E)) + 1.0f); }
__device__ __forceinline__ f32x4 silu4(f32x4 x) { return x * sigmoid4(x); }
template <int CTRL> __device__ __forceinline__ float dppf(float old, float src) {
    return __builtin_bit_cast(float, __builtin_amdgcn_update_dpp(__builtin_bit_cast(int, old), __builtin_bit_cast(int, src), CTRL, 0xf, 0xf, false));
}
template <int CTRL> __device__ __forceinline__ f32x4 dpp4(f32x4 old, f32x4 s) { return (f32x4){dppf<CTRL>(old[0], s[0]), dppf<CTRL>(old[1], s[1]), dppf<CTRL>(old[2], s[2]), dppf<CTRL>(old[3], s[3])}; }
#define DPP_ROR(n) (0x120 + (n))
#define DPP_SHR(n) (0x110 + (n))
#define DPP_SHL(n) (0x100 + (n))
#define DPP_BCAST(n) (0x150 + (n))
__device__ __forceinline__ f32x4 sel4(bool c, f32x4 a, f32x4 b) { return c ? a : b; }
__device__ __forceinline__ int fresh_lane() { unsigned z; asm volatile("s_mov_b32 %0, 0" : "=s"(z)); return (int)__builtin_amdgcn_mbcnt_hi(~0u, __builtin_amdgcn_mbcnt_lo(~0u, z)); }
#define LDS_WAIT() asm volatile("s_waitcnt lgkmcnt(0)" ::: "memory")
#define VM_WAIT() asm volatile("s_waitcnt vmcnt(0)" ::: "memory")
#define WG_BAR() do { asm volatile("s_waitcnt lgkmcnt(0)" ::: "memory"); __builtin_amdgcn_s_barrier(); asm volatile("" ::: "memory"); } while (0)

namespace pg8 {
constexpr int BM = 256, BK = 64, HALF = 128, HTB = HALF * BK * 2, STAGE_BYTES = 8 * HTB, NXCD = 8;
#ifndef WGM_DEFAULT
#define WGM_DEFAULT 6
#endif
#ifndef WGM_G23
#define WGM_G23 4
#endif
constexpr int WGM_UNUSED = 0;
__host__ __device__ __forceinline__ int lds_byte(int r, int c) { const int st = (r >> 4) * 2 + (c >> 5), rr = r & 15, cc = c & 31, ob = rr * 64 + cc * 2; return st * 1024 + (ob ^ (((ob >> 9) & 1) << 5)); }
__host__ __device__ __forceinline__ void stage_rc(int b, int& R, int& C) { const int st = b / 1024, sb = b % 1024, swz = sb ^ (((sb >> 9) & 1) << 5); R = (st >> 1) * 16 + swz / 64; C = (st & 1) * 32 + (swz % 64) / 2; }

struct Unit { int pm, pn, kk, pos, bb, plo; };
struct Gemm {
    const bf16_t* A; const bf16_t* Bt; int lda, ldb, K; int a_kk, b_kk; int a_pn_shift, a_pn_mul; int a_perm;
    __device__ __forceinline__ const char* a_ptr(const Unit& u) const { return (const char*)(A + (size_t)u.pm * 256 * lda + (size_t)u.kk * a_kk + (size_t)(u.pn >> a_pn_shift) * a_pn_mul); }
    __device__ __forceinline__ const char* b_ptr(const Unit& u) const { return (const char*)(Bt + (size_t)u.pn * 256 * ldb + (size_t)u.kk * b_kk); }
};
struct Sched {
    int nM, nN, G, c, kdiv, nmain, extra_n, extra_pm0, extra_pn0, extra_npn, pass_dir, extra_first, list_off, extra_sh, late_n, late_r, wgm;
    __device__ __forceinline__ void init(int nM_, int nN_, int G_, int c_, int kdiv_ = 1, int extra_n_ = 0, int epm0 = 0, int epn0 = 0, int enpn = 1) {
        nM = nM_; nN = nN_; G = G_; c = c_; kdiv = kdiv_; nmain = nM * nN; extra_n = extra_n_; extra_pm0 = epm0; extra_pn0 = epn0; extra_npn = enpn; pass_dir = -1; extra_first = 0; list_off = -1; extra_sh = 31 - __builtin_clz((unsigned)enpn); late_n = 0; late_r = 0; wgm = WGM_DEFAULT; }
    __device__ __forceinline__ void init_pass(int G_, int c_, int dir) { init(0, 1, G_, c_); pass_dir = dir; }
    __device__ __forceinline__ bool next(int i, Unit& u) const {
        u.pos = 0; u.bb = 0; u.plo = 0;
        if (pass_dir >= 0) {
            const int L = i * G + c; if (L >= 32 * 16) return false;
            const int pos = (L >> 4) + 1, bb = L & 15, b = bb >> 3;
            u.pm = pass_dir == 0 ? 32 * b + pos - 1 : 32 * b + 32 - pos; u.pn = bb & 7; u.kk = 0;
            u.pos = pos; u.bb = bb; u.plo = ((i * G - bb + 15) >> 4) + 1; return true;
        }
        const int ti = (kdiv == 2) ? (i >> 1) : i; u.kk = (kdiv == 2) ? (i & 1) : 0;
        if (list_off >= 0) {
            const int e = ti * G + c - list_off; if (e < 0 || e >= extra_n) return false;
            u.pm = extra_pm0 + (e >> extra_sh); u.pn = extra_pn0 + (e & (extra_npn - 1)); return true;
        }
        long L = (long)ti * G + c;
        if (late_n > 0) {
            if (c < late_n) {
                if (i == 0) { u.pm = 64 + (c >> 2); u.pn = 16 + (c & 3); return true; }
                L = (long)late_r * (G - late_n) + (long)(i - 1) * G + c;
            } else L = i < late_r ? (long)i * (G - late_n) + (c - late_n) : (long)late_r * (G - late_n) + (long)(i - late_r) * G + c;
            if (L >= nmain) return false;
        }
        if (extra_first) {
            if (L < extra_n) { const int e = (int)L; u.pm = extra_pm0 + (e >> extra_sh); u.pn = extra_pn0 + (e & (extra_npn - 1)); return true; }
            L -= extra_n; if (L >= nmain) return false;
        }
        if (L < nmain) {
            int wgid = (int)L; { const int q = nmain / NXCD, r = nmain % NXCD, xcd = wgid % NXCD, off = wgid / NXCD; wgid = (xcd < r ? xcd * (q + 1) : r * (q + 1) + (xcd - r) * q) + off; }
            const int nig = wgm * nN, gid = wgid / nig, fm = gid * wgm, gsz = (nM - fm) < wgm ? (nM - fm) : wgm;
            u.pm = fm + ((wgid % nig) % gsz); u.pn = (wgid % nig) / gsz; return true;
        }
        const int e = (int)(L - nmain); if (e >= extra_n) return false;
        u.pm = extra_pm0 + (e >> extra_sh); u.pn = extra_pn0 + (e & (extra_npn - 1)); return true;
    }
};

template <class T, class = void> struct epi_after_drain { static constexpr bool value = false; };
template <class T> struct epi_after_drain<T, decltype((void)T::AFTER_DRAIN)> { static constexpr bool value = T::AFTER_DRAIN; };
template <class Epi>
__device__ __forceinline__ void gemm_phase(LAS unsigned char* lds, const Gemm g, const Sched& S, const Epi& E, int wave_) {
    const int tid_ = fresh_lane() + wave_ * 64;
    const int tid = tid_, wid = __builtin_amdgcn_readfirstlane(tid >> 6), lane = tid & 63, wr = wid >> 2, wc = wid & 3, fr = lane & 15, fq = lane >> 4;
    int K_ = g.K; asm volatile("" : "+s"(K_));
    const int K = K_, nt = K / BK;
    unsigned voffA, voffB;
    { int R, C; stage_rc(tid * 16, R, C); const int Rp = g.a_perm ? 4 * (R & 15) + (R >> 4) : R; voffA = (unsigned)(Rp * g.lda + C) * 2u; voffB = (unsigned)(R * g.ldb + C) * 2u; }
    const size_t qvoffA = (size_t)64 * g.lda * 2, qvoffB = (size_t)64 * g.ldb * 2;
    const size_t kstep = (size_t)(BK * 2);
    const size_t hstepA = (size_t)HALF * g.lda * 2, hstepB = (size_t)HALF * g.ldb * 2;
    const unsigned ldsw = (unsigned)wid * 1024u;
    const int aoff = lds_byte(wr * 64 + fr, fq * 8), boff = lds_byte(wc * 32 + fr, fq * 8);
#define PG8_SA(b, h) (((b) * 2 + (h)) * HTB)
#define PG8_SB(b, h) ((4 + (b) * 2 + (h)) * HTB)
#define PG8_STAGE(bufoff, gbase, voff) do { _Pragma("unroll") for (int _i = 0; _i < 2; ++_i) \
        __builtin_amdgcn_global_load_lds((const unsigned*)((const char*)(gbase) + (size_t)_i * q##voff + (voff)), (LAS unsigned*)(lds + (bufoff) + ldsw + _i * 8192), 16, 0, 0); } while (0)
#define PG8_LDA(dst, b, h) do { _Pragma("unroll") for (int m = 0; m < 4; ++m) _Pragma("unroll") for (int k = 0; k < 2; ++k) dst[m][k] = *(const LAS bf16x8*)(lds + PG8_SA(b, h) + aoff + m * 2048 + k * 1024); } while (0)
#define PG8_LDB(dst, b, h) do { _Pragma("unroll") for (int n = 0; n < 2; ++n) _Pragma("unroll") for (int k = 0; k < 2; ++k) dst[n][k] = *(const LAS bf16x8*)(lds + PG8_SB(b, h) + boff + n * 2048 + k * 1024); } while (0)
#define PG8_MMA(ai, bj, At, Bt) do { __builtin_amdgcn_s_setprio(1); _Pragma("unroll") for (int m = 0; m < 4; ++m) _Pragma("unroll") for (int n = 0; n < 2; ++n) _Pragma("unroll") for (int k = 0; k < 2; ++k) \
        acc[ai][bj][m][n] = __builtin_amdgcn_mfma_f32_16x16x32_bf16(Bt[n][k], At[m][k], acc[ai][bj][m][n], 0, 0, 0); __builtin_amdgcn_s_setprio(0); } while (0)
#define PG8_WAIT_V(n) asm volatile("s_waitcnt vmcnt(" #n ")" ::: "memory")
#define PG8_WAIT_L(n) asm volatile("s_waitcnt lgkmcnt(" #n ")" ::: "memory")
#define PG8_BAR __builtin_amdgcn_s_barrier()
#define PG8_SCHED __builtin_amdgcn_sched_barrier(0)
    Unit cur, nxt; int ui = 0;
    if (!S.next(0, cur)) return;
    f32x4 acc[2][2][4][2];
#pragma unroll
    for (int a = 0; a < 2; ++a)
#pragma unroll
        for (int b = 0; b < 2; ++b)
#pragma unroll
            for (int m = 0; m < 4; ++m)
#pragma unroll
                for (int n = 0; n < 2; ++n) acc[a][b][m][n] = (f32x4){0.f, 0.f, 0.f, 0.f};
    bf16x8 At[4][2], B0[2][2], B1[2][2];
    const char* cA = g.a_ptr(cur); const char* cB = g.b_ptr(cur);
    PG8_STAGE(PG8_SB(0, 0), cB, voffB); PG8_STAGE(PG8_SB(0, 1), cB + hstepB, voffB); PG8_STAGE(PG8_SA(0, 0), cA, voffA); PG8_STAGE(PG8_SA(0, 1), cA + hstepA, voffA);
    if (wr == 1) PG8_BAR;
    PG8_WAIT_V(2); PG8_BAR;
    PG8_STAGE(PG8_SB(1, 0), cB + kstep, voffB); PG8_STAGE(PG8_SA(1, 0), cA + kstep, voffA); PG8_STAGE(PG8_SB(1, 1), cB + hstepB + kstep, voffB);
    PG8_WAIT_V(6); PG8_BAR;
    for (;;) {
        const bool has_next = S.next(ui + 1, nxt);
        const char* nA = has_next ? g.a_ptr(nxt) : cA; const char* nB = has_next ? g.b_ptr(nxt) : cB;
        for (int t = 0; t < nt; t += 2) {
            const bool last = (t == nt - 2);
            const char* a1 = cA + (size_t)(t + 1) * kstep;
            const char* a2 = last ? nA : cA + (size_t)(t + 2) * kstep; const char* b2 = last ? nB : cB + (size_t)(t + 2) * kstep;
            const char* a3 = a2 + kstep; const char* b3 = b2 + kstep;
            PG8_LDB(B0, 0, 0); PG8_LDB(B1, 0, 1); PG8_SCHED; PG8_LDA(At, 0, 0); PG8_STAGE(PG8_SA(1, 1), a1 + hstepA, voffA);
            PG8_WAIT_V(8); PG8_WAIT_L(0); PG8_BAR; PG8_MMA(0, 0, At, B0); PG8_MMA(0, 1, At, B1); PG8_BAR; PG8_SCHED;
            PG8_LDA(At, 0, 1); PG8_STAGE(PG8_SB(0, 0), b2, voffB); PG8_STAGE(PG8_SB(0, 1), b2 + hstepB, voffB); PG8_STAGE(PG8_SA(0, 0), a2, voffA);
            PG8_WAIT_V(8); PG8_WAIT_L(0); PG8_BAR; PG8_MMA(1, 0, At, B0); PG8_MMA(1, 1, At, B1); PG8_BAR; PG8_SCHED;
            PG8_LDB(B0, 1, 0); PG8_LDB(B1, 1, 1); PG8_SCHED; PG8_LDA(At, 1, 0); PG8_STAGE(PG8_SA(0, 1), a2 + hstepA, voffA);
            PG8_WAIT_V(8); PG8_WAIT_L(0); PG8_BAR; PG8_MMA(0, 0, At, B0); PG8_MMA(0, 1, At, B1); PG8_BAR; PG8_SCHED;
            PG8_LDA(At, 1, 1); PG8_STAGE(PG8_SB(1, 0), b3, voffB); PG8_STAGE(PG8_SB(1, 1), b3 + hstepB, voffB); PG8_STAGE(PG8_SA(1, 0), a3, voffA);
            PG8_WAIT_V(8); PG8_WAIT_L(0); PG8_BAR; PG8_MMA(1, 0, At, B0); PG8_MMA(1, 1, At, B1); PG8_BAR; PG8_SCHED;
        }
        if (wr == 0) PG8_BAR;
        const int eln = fresh_lane();
        const int efr = eln & 15, efq = eln >> 4; int ewr = wr, ewc = wc; asm volatile("" : "+s"(ewr), "+s"(ewc));
        bool keep = false;
        if constexpr (!epi_after_drain<Epi>::value) keep = E(acc, cur, ewr, ewc, efr, efq);
        if (!has_next) break;
        if (!keep) {
#pragma unroll
            for (int a = 0; a < 2; ++a)
#pragma unroll
                for (int b = 0; b < 2; ++b)
#pragma unroll
                    for (int m = 0; m < 4; ++m)
#pragma unroll
                        for (int n = 0; n < 2; ++n) acc[a][b][m][n] = (f32x4){0.f, 0.f, 0.f, 0.f};
        }
        cur = nxt; cA = nA; cB = nB; ++ui;
        if (wr == 1) PG8_BAR;
    }
    PG8_WAIT_V(0);
    PG8_BAR;
    if constexpr (epi_after_drain<Epi>::value) { const int eln = fresh_lane(); int ewr = wr, ewc = wc; asm volatile("" : "+s"(ewr), "+s"(ewc)); E.final(acc, cur, ewr, ewc, eln, lds); }
#undef PG8_SA
#undef PG8_SB
#undef PG8_STAGE
#undef PG8_LDA
#undef PG8_LDB
#undef PG8_MMA
#undef PG8_WAIT_V
#undef PG8_WAIT_L
#undef PG8_BAR
#undef PG8_SCHED
}

template <class Epi>
__device__ __forceinline__ void pass_phase(LAS unsigned char* lds, const Gemm g, const Sched& S, const Epi& E, int wave_) {
    const int tid = fresh_lane() + wave_ * 64;
    const int wid = __builtin_amdgcn_readfirstlane(tid >> 6), lane = tid & 63, wr = wid >> 2, wc = wid & 3, fr = lane & 15, fq = lane >> 4;
    unsigned voffA, voffB;
    { int R, C; stage_rc(tid * 16, R, C); voffA = (unsigned)((4 * (R & 15) + (R >> 4)) * g.lda + C) * 2u; voffB = (unsigned)(R * g.ldb + C) * 2u; }
    const size_t qvoffA = (size_t)64 * g.lda * 2, qvoffB = (size_t)64 * g.ldb * 2;
    const size_t kstep = (size_t)(BK * 2), hstepA = (size_t)HALF * g.lda * 2, hstepB = (size_t)HALF * g.ldb * 2;
    const unsigned ldsw = (unsigned)wid * 1024u;
    const int aoff = lds_byte(wr * 64 + fr, fq * 8), boff = lds_byte(wc * 32 + fr, fq * 8);
#define PP_SA(b, h) (((b) * 2 + (h)) * HTB)
#define PP_SB(b, h) ((4 + (b) * 2 + (h)) * HTB)
#define PP_STAGE(bufoff, gbase, voff) do { _Pragma("unroll") for (int _i = 0; _i < 2; ++_i) \
        __builtin_amdgcn_global_load_lds((const unsigned*)((const char*)(gbase) + (size_t)_i * q##voff + (voff)), (LAS unsigned*)(lds + (bufoff) + ldsw + _i * 8192), 16, 0, 0); } while (0)
#define PP_STAGE_A(ap) do { PP_STAGE(PP_SA(0, 0), (ap), voffA); PP_STAGE(PP_SA(0, 1), (ap) + hstepA, voffA); PP_STAGE(PP_SA(1, 0), (ap) + kstep, voffA); PP_STAGE(PP_SA(1, 1), (ap) + hstepA + kstep, voffA); } while (0)
#define PP_STAGE_B(bp) do { PP_STAGE(PP_SB(0, 0), (bp), voffB); PP_STAGE(PP_SB(0, 1), (bp) + hstepB, voffB); PP_STAGE(PP_SB(1, 0), (bp) + kstep, voffB); PP_STAGE(PP_SB(1, 1), (bp) + hstepB + kstep, voffB); } while (0)
    Unit cur, nxt; int ui = 0;
    if (!S.next(0, cur)) return;
    PP_STAGE_B(g.b_ptr(cur)); PP_STAGE_A(g.a_ptr(cur));
    for (;;) {
        const bool has_next = S.next(ui + 1, nxt);
        asm volatile("s_waitcnt vmcnt(0)" ::: "memory"); __builtin_amdgcn_s_barrier(); asm volatile("" ::: "memory");
        f32x4 acc[2][2][4][2];
#pragma unroll
        for (int a = 0; a < 2; ++a)
#pragma unroll
            for (int b = 0; b < 2; ++b)
#pragma unroll
                for (int m = 0; m < 4; ++m)
#pragma unroll
                    for (int n = 0; n < 2; ++n) acc[a][b][m][n] = (f32x4){0.f, 0.f, 0.f, 0.f};
#pragma unroll
        for (int b = 0; b < 2; ++b) {
            bf16x8 B0[2][2], B1[2][2];
#pragma unroll
            for (int n = 0; n < 2; ++n)
#pragma unroll
                for (int k = 0; k < 2; ++k) { B0[n][k] = *(const LAS bf16x8*)(lds + PP_SB(b, 0) + boff + n * 2048 + k * 1024); B1[n][k] = *(const LAS bf16x8*)(lds + PP_SB(b, 1) + boff + n * 2048 + k * 1024); }
#pragma unroll
            for (int h = 0; h < 2; ++h) {
                bf16x8 At[4][2];
#pragma unroll
                for (int m = 0; m < 4; ++m)
#pragma unroll
                    for (int k = 0; k < 2; ++k) At[m][k] = *(const LAS bf16x8*)(lds + PP_SA(b, h) + aoff + m * 2048 + k * 1024);
#pragma unroll
                for (int m = 0; m < 4; ++m)
#pragma unroll
                    for (int n = 0; n < 2; ++n)
#pragma unroll
                        for (int k = 0; k < 2; ++k) { acc[h][0][m][n] = __builtin_amdgcn_mfma_f32_16x16x32_bf16(B0[n][k], At[m][k], acc[h][0][m][n], 0, 0, 0);
                                                      acc[h][1][m][n] = __builtin_amdgcn_mfma_f32_16x16x32_bf16(B1[n][k], At[m][k], acc[h][1][m][n], 0, 0, 0); }
            }
        }
        struct AfterGates { LAS unsigned char* lds; const char* nA; const char* nB; unsigned voffA, voffB, ldsw; size_t qvoffA, qvoffB, kstep, hstepA, hstepB; bool stage_a, stage_b;
            __device__ __forceinline__ void operator()() const {
                asm volatile("s_waitcnt lgkmcnt(0)" ::: "memory"); __builtin_amdgcn_s_barrier(); asm volatile("" ::: "memory");
                if (stage_b) PP_STAGE_B(nB);
                if (stage_a) PP_STAGE_A(nA);
            } };
        const AfterGates ag{lds, has_next ? g.a_ptr(nxt) : nullptr, has_next ? g.b_ptr(nxt) : nullptr, voffA, voffB, ldsw, qvoffA, qvoffB, kstep, hstepA, hstepB, has_next, has_next && (nxt.pn != cur.pn)};
        int eln = fresh_lane(); const int efr = eln & 15, efq = eln >> 4; int ewr = wr, ewc = wc; asm volatile("" : "+s"(ewr), "+s"(ewc));
        E.run(acc, cur, ewr, ewc, efr, efq, ag);
        if (!has_next) break;
        cur = nxt; ++ui;
    }
    asm volatile("s_waitcnt vmcnt(0)" ::: "memory"); __builtin_amdgcn_s_barrier();
#undef PP_SA
#undef PP_SB
#undef PP_STAGE
#undef PP_STAGE_A
#undef PP_STAGE_B
}
}
using pg8::Unit;
typedef f32x4 Acc[2][2][4][2];

struct EpiG1 {
    bf16_t* BIG; bf16_t* XC; bf16_t* SZB; bf16_t* RAT; bf16_t* SMB;
    const float* w3; const float* w4; const float* b4;
    LAS float* scr;
    unsigned* ctxcnt;
    __device__ __forceinline__ bool operator()(Acc& acc, const Unit& u, int wr, int wc, int fr, int fq) const {
        const int pm = u.pm, pn = u.pn;
        const bool isctx = pm >= 64;
        const unsigned row0 = (unsigned)pm * 256 + wr * 64 + 4 * fr;
        const f32x4 zero4 = (f32x4){0.f, 0.f, 0.f, 0.f};
        if (pn < 16) {
            const int ch0 = 64 * pn + 16 * wc + 4 * fq;
            const f32x4 w0 = *(const f32x4*)(w3 + ch0), w1 = *(const f32x4*)(w3 + 1024 + ch0), w2 = *(const f32x4*)(w3 + 2048 + ch0);
#pragma unroll
            for (int ai = 0; ai < 2; ++ai)
#pragma unroll
                for (int m = 0; m < 4; ++m) acc[ai][0][m][0] = acc[ai][0][m][0] * acc[ai][0][m][1];
            const int col = 16 * wc + 4 * fq;
            if (isctx) {
#pragma unroll
                for (int ai = 0; ai < 2; ++ai) { const int seg = 2 * ai + wr;
                    if (fr == 0) *(LAS f32x4*)(scr + (seg * 2 + 0) * 64 + col) = acc[ai][0][0][0];
                    if (fr == 15) *(LAS f32x4*)(scr + (seg * 2 + 1) * 64 + col) = acc[ai][0][3][0]; }
                WG_BAR();
            }
#pragma unroll
            for (int ai = 0; ai < 2; ++ai) {
                const int seg = 2 * ai + wr;
                f32x4 hp = zero4, hn = zero4;
                if (isctx) { if (seg > 0) hp = *(const LAS f32x4*)(scr + ((seg - 1) * 2 + 1) * 64 + col); if (seg < 3) hn = *(const LAS f32x4*)(scr + ((seg + 1) * 2 + 0) * 64 + col); }
                const f32x4 pl = dpp4<DPP_SHR(1)>(hp, acc[ai][0][3][0]);
                const f32x4 nf = dpp4<DPP_SHL(1)>(hn, acc[ai][0][0][0]);
#pragma unroll
                for (int m = 0; m < 4; ++m) {
                    const f32x4 prev = m > 0 ? acc[ai][0][m > 0 ? m - 1 : 0][0] : pl;
                    const f32x4 next = m < 3 ? acc[ai][0][m < 3 ? m + 1 : 3][0] : nf;
                    const f32x4 cv = w0 * prev + w1 * acc[ai][0][m][0] + w2 * next;
                    const f32x4 y = acc[ai][1][m][0] * cv * silu4(acc[ai][1][m][1]);
                    *(u32x2*)(BIG + (size_t)(row0 + ai * 128 + m) * 2048 + ch0) = pack4(y);
                }
            }
            if (isctx) WG_BAR();
        } else if (pn < 20) {
            if (isctx) {
#pragma unroll
                for (int ai = 0; ai < 2; ++ai) { const int seg = 2 * ai + wr;
#pragma unroll
                    for (int bj = 0; bj < 2; ++bj)
#pragma unroll
                        for (int n = 0; n < 2; ++n) { const int col = 128 * bj + 32 * wc + 16 * n + 4 * fq;
                            if (fr == 0) *(LAS f32x4*)(scr + (seg * 3 + 0) * 256 + col) = acc[ai][bj][0][n];
                            if (fr == 15) *(LAS f32x4*)(scr + (seg * 3 + 1) * 256 + col) = acc[ai][bj][2][n];
                            if (fr == 15) *(LAS f32x4*)(scr + (seg * 3 + 2) * 256 + col) = acc[ai][bj][3][n]; } }
                WG_BAR();
            }
#pragma unroll
            for (int bj = 0; bj < 2; ++bj) {
                const int ch0 = 256 * (pn - 16) + 128 * bj + 32 * wc + 8 * fq;
#pragma unroll
                for (int ai = 0; ai < 2; ++ai) {
                    const int seg = 2 * ai + wr;
                    u32x2 pk[4];
#pragma unroll
                    for (int n = 0; n < 2; ++n) {
                        const int ch = ch0 + 4 * n, col = 128 * bj + 32 * wc + 16 * n + 4 * fq;
                        const f32x4 k0 = *(const f32x4*)(w4 + ch), k1 = *(const f32x4*)(w4 + 1024 + ch), k2 = *(const f32x4*)(w4 + 2048 + ch), k3 = *(const f32x4*)(w4 + 3072 + ch), kb = *(const f32x4*)(b4 + ch);
                        f32x4 hp1 = zero4, hp2 = zero4, hn1 = zero4;
                        if (isctx) {
                            if (seg > 0) { hp2 = *(const LAS f32x4*)(scr + ((seg - 1) * 3 + 1) * 256 + col); hp1 = *(const LAS f32x4*)(scr + ((seg - 1) * 3 + 2) * 256 + col); }
                            if (seg < 3) hn1 = *(const LAS f32x4*)(scr + ((seg + 1) * 3 + 0) * 256 + col); }
                        const f32x4 s3 = dpp4<DPP_SHR(1)>(hp1, acc[ai][bj][3][n]), s2 = dpp4<DPP_SHR(1)>(hp2, acc[ai][bj][2][n]);
                        const f32x4 nx = dpp4<DPP_SHL(1)>(hn1, acc[ai][bj][0][n]);
#pragma unroll
                        for (int m = 0; m < 4; ++m) {
                            const f32x4 x = acc[ai][bj][m][n];
                            const f32x4 p1 = m > 0 ? acc[ai][bj][m > 0 ? m - 1 : 0][n] : s3;
                            const f32x4 p2 = m > 1 ? acc[ai][bj][m > 1 ? m - 2 : 0][n] : (m == 1 ? s3 : s2);
                            const f32x4 n1 = m < 3 ? acc[ai][bj][m < 3 ? m + 1 : 3][n] : nx;
                            const f32x4 o = k0 * p2 + k1 * p1 + k2 * x + k3 * n1 + kb;
                            if (n == 0) pk[m] = pack4(o);
                            else { const u32x2 b = pack4(o); *(u32x4*)(XC + (size_t)(row0 + ai * 128 + m) * 1024 + ch0) = (u32x4){pk[m].x, pk[m].y, b.x, b.y}; }
                        }
                    }
                }
            }
            if (isctx) WG_BAR();
        } else if (pn < 24) {
#pragma unroll
            for (int bj = 0; bj < 2; ++bj) { const int ch0 = 256 * (pn - 20) + 128 * bj + 32 * wc + 8 * fq;
#pragma unroll
                for (int ai = 0; ai < 2; ++ai)
#pragma unroll
                    for (int m = 0; m < 4; ++m) { const u32x2 a = pack4(silu4(acc[ai][bj][m][0])), b = pack4(silu4(acc[ai][bj][m][1]));
                        *(u32x4*)(SZB + (size_t)(row0 + ai * 128 + m) * 1024 + ch0) = (u32x4){a.x, a.y, b.x, b.y}; } }
        } else {
            const int ch0 = 128 * (pn - 24) + 32 * wc + 8 * fq;
#pragma unroll
            for (int ai = 0; ai < 2; ++ai)
#pragma unroll
                for (int m = 0; m < 4; ++m) {
                    const float nl = opaque_f(-LOG2E);
                    const f32x4 pa0 = exp2_4(acc[ai][0][m][0] * nl) + 1.0f, pa1 = exp2_4(acc[ai][0][m][1] * nl) + 1.0f, pb0 = exp2_4(acc[ai][1][m][0] * nl) + 1.0f, pb1 = exp2_4(acc[ai][1][m][1] * nl) + 1.0f;
                    const f32x4 sb0 = rcp4(pb0), sb1 = rcp4(pb1);
                    const f32x4 q0 = pb0 * rcp4(pa0), q1 = pb1 * rcp4(pa1);
                    const size_t off = (size_t)(row0 + ai * 128 + m) * 1024 + ch0;
                    { const u32x2 a = pack4(q0), b = pack4(q1); *(u32x4*)(RAT + off) = (u32x4){a.x, a.y, b.x, b.y}; }
                    { const u32x2 a = pack4(sb0), b = pack4(sb1); *(u32x4*)(SMB + off) = (u32x4){a.x, a.y, b.x, b.y}; }
                }
        }
        if (isctx) {
            asm volatile("s_waitcnt vmcnt(0)" ::: "memory"); WG_BAR();
            if (wr == 0 && wc == 0 && fq == 0 && fr == 0) { __builtin_amdgcn_fence(__ATOMIC_RELEASE, "agent"); asm volatile("s_waitcnt vmcnt(0)" ::: "memory");
                __hip_atomic_fetch_add(ctxcnt, 1u, __ATOMIC_RELAXED, __HIP_MEMORY_SCOPE_AGENT); }
        }
        return false;
    }
};

typedef unsigned long long u64;
__device__ __forceinline__ void gr_store(u64* p, unsigned epoch, float v) { __hip_atomic_store(p, ((u64)epoch << 32) | (u64)__float_as_uint(v), __ATOMIC_RELAXED, __HIP_MEMORY_SCOPE_AGENT); }
__device__ __forceinline__ u64 gr_load(const u64* p) { return __hip_atomic_load(p, __ATOMIC_RELAXED, __HIP_MEMORY_SCOPE_AGENT); }
template <int DIR> struct EpiP {
    const bf16_t* XC; const bf16_t* SZB; bf16_t* BIG;
    const float* br; const float* bi; const float* clam;
    u64* gran; unsigned* tmo; unsigned epoch;
    LAS float* scr;
    const LAS unsigned char* xlds;
    template <class AfterGates> __device__ __forceinline__ bool run(Acc& acc, const Unit& u, int wr, int wc, int fr, int fq, const AfterGates& after_gates) const {
        const int pm = u.pm, blk = u.pn;
        const int cl = 32 * wc + 8 * fq; const unsigned chb = 128 * blk + cl;
        const unsigned row0 = (unsigned)pm * 256 + wr * 64 + 4 * fr;
        const int tq = (wr * 4 + wc) * 64 + fq * 16 + fr;
        u32x4 xw[2][4];
#pragma unroll
        for (int ai = 0; ai < 2; ++ai)
#pragma unroll
            for (int m = 0; m < 4; ++m) xw[ai][m] = *(const LAS u32x4*)(xlds + ((wc >> 1) * 2 + ai) * pg8::HTB + pg8::lds_byte(wr * 64 + 16 * m + fr, cl & 63));
        const float nl2e = opaque_f(-LOG2E), m1 = opaque_f(-1.0f);
#pragma unroll
        for (int n = 0; n < 2; ++n) {
            const int ch0 = chb + 4 * n;
            const f32x4 brv = *(const f32x4*)(br + ch0) * (-LOG2E), biv = *(const f32x4*)(bi + ch0) * (-LOG2E);
            const f32x4 cv = *(const f32x4*)(clam + ch0) * LOG2E;
#pragma unroll
            for (int ai = 0; ai < 2; ++ai)
#pragma unroll
                for (int m = 0; m < 4; ++m) {
                    const f32x4 x = unpack4(n == 0 ? (u32x2){xw[ai][m].x, xw[ai][m].y} : (u32x2){xw[ai][m].z, xw[ai][m].w});
                    const f32x4 tr = acc[ai][0][m][n] * nl2e + brv, ti = acc[ai][1][m][n] * nl2e + biv;
                    const f32x4 r = rcp4(exp2_4(tr) + 1.0f), pi = exp2_4(ti) + 1.0f;
                    const f32x4 a = exp2_4(cv * r);
                    const f32x4 w = (a * a) * m1 + 1.0f;
                    acc[ai][0][m][n] = a; acc[ai][1][m][n] = (w * rsq4((pi * pi) * w + 1e-30f)) * x;
                    __builtin_amdgcn_sched_barrier(0);
                }
        }
        after_gates();
#define SCAN_STEP(SH) \
        "v_fmac_f32_dpp %0, %0, %4 " SH " row_mask:0xf bank_mask:0xf\n\tv_fmac_f32_dpp %1, %1, %5 " SH " row_mask:0xf bank_mask:0xf\n\t" \
        "v_fmac_f32_dpp %2, %2, %6 " SH " row_mask:0xf bank_mask:0xf\n\tv_fmac_f32_dpp %3, %3, %7 " SH " row_mask:0xf bank_mask:0xf\n\t" \
        "v_mul_f32_dpp %4, %4, %4 " SH " row_mask:0xf bank_mask:0xf\n\tv_mul_f32_dpp %5, %5, %5 " SH " row_mask:0xf bank_mask:0xf\n\t" \
        "v_mul_f32_dpp %6, %6, %6 " SH " row_mask:0xf bank_mask:0xf\n\tv_mul_f32_dpp %7, %7, %7 " SH " row_mask:0xf bank_mask:0xf\n\t"
#define SCAN_CARRY(BC) \
        "v_fmac_f32_dpp %0, %8, %4 " BC " row_mask:0xf bank_mask:0xf\n\tv_fmac_f32_dpp %1, %9, %5 " BC " row_mask:0xf bank_mask:0xf\n\t" \
        "v_fmac_f32_dpp %2, %10, %6 " BC " row_mask:0xf bank_mask:0xf\n\tv_fmac_f32_dpp %3, %11, %7 " BC " row_mask:0xf bank_mask:0xf\n\t" \
        "v_mul_f32_dpp %4, %12, %4 " BC " row_mask:0xf bank_mask:0xf\n\tv_mul_f32_dpp %5, %13, %5 " BC " row_mask:0xf bank_mask:0xf\n\t" \
        "v_mul_f32_dpp %6, %14, %6 " BC " row_mask:0xf bank_mask:0xf\n\tv_mul_f32_dpp %7, %15, %7 " BC " row_mask:0xf bank_mask:0xf\n\t"
#define SCAN_OUT(A, L) "+v"(L[0]), "+v"(L[1]), "+v"(L[2]), "+v"(L[3]), "+v"(A[0]), "+v"(A[1]), "+v"(A[2]), "+v"(A[3])
#define SCAN_IN(A, L) "v"(L[0]), "v"(L[1]), "v"(L[2]), "v"(L[3]), "v"(A[0]), "v"(A[1]), "v"(A[2]), "v"(A[3])
#pragma unroll
        for (int ai = 0; ai < 2; ++ai) {
#pragma unroll
            for (int n = 0; n < 2; ++n) {
                if constexpr (DIR == 0) {
#pragma unroll
                    for (int m = 1; m < 4; ++m) { acc[ai][1][m][n] = acc[ai][0][m][n] * acc[ai][1][m - 1][n] + acc[ai][1][m][n]; acc[ai][0][m][n] = acc[ai][0][m][n] * acc[ai][0][m - 1][n]; }
                    asm volatile("s_nop 1\n\t" SCAN_STEP("row_shr:1") SCAN_STEP("row_shr:2") SCAN_STEP("row_shr:4") SCAN_STEP("row_shr:8") "s_nop 1" : SCAN_OUT(acc[ai][0][3][n], acc[ai][1][3][n]));
                } else {
#pragma unroll
                    for (int m = 2; m >= 0; --m) { acc[ai][1][m][n] = acc[ai][0][m][n] * acc[ai][1][m + 1][n] + acc[ai][1][m][n]; acc[ai][0][m][n] = acc[ai][0][m][n] * acc[ai][0][m + 1][n]; }
                    asm volatile("s_nop 1\n\t" SCAN_STEP("row_shl:1") SCAN_STEP("row_shl:2") SCAN_STEP("row_shl:4") SCAN_STEP("row_shl:8") "s_nop 1" : SCAN_OUT(acc[ai][0][0][n], acc[ai][1][0][n]));
                }
                const int seg = 2 * ai + wr;
                if (fr == (DIR == 0 ? 15 : 0)) {
#pragma unroll
                    for (int j = 0; j < 4; ++j) *(LAS f32x2*)(scr + (seg * 128 + cl + 4 * n + j) * 2) = (f32x2){acc[ai][0][DIR == 0 ? 3 : 0][n][j], acc[ai][1][DIR == 0 ? 3 : 0][n][j]};
                }
            }
        }
#undef SCAN_STEP
#undef SCAN_CARRY
#undef SCAN_OUT
#undef SCAN_IN
        u32x4 hfw[4], zw[4];
        if constexpr (DIR == 1) {
#pragma unroll
            for (int m = 0; m < 4; ++m) { const unsigned r = row0 + m; hfw[m] = *(const u32x4*)(BIG + (r * 2048u + 1024u + chb)); zw[m] = *(const u32x4*)(SZB + (r * 1024u + chb)); }
        }
        WG_BAR();
        {
            LAS float* part = scr + 1024; LAS float* car = scr + 2048;
            const int c = tq & 127, g = tq >> 7, pos = u.pos, npre = pos - u.plo;
            u64* const gA = gran + (size_t)u.bb * 128 + c; u64* const gB = gA + GR_N; u64* const gP = gA + 2 * GR_N;
            float At = 1.f, Bt = 0.f; f32x2 tb[4];
            if (tq < 128) {
#pragma unroll
                for (int s = 0; s < 4; ++s) { const int seg = DIR == 0 ? s : 3 - s; tb[s] = *(const LAS f32x2*)(scr + (seg * 128 + c) * 2); Bt = tb[s].x * Bt + tb[s].y; At = At * tb[s].x; }
                gr_store(gA + (size_t)pos * 2048, epoch, At); gr_store(gB + (size_t)pos * 2048, epoch, Bt);
            }
            float Ap = 1.f, Bp = 0.f, hbase = 0.f;
            {
                u64 ga[4], gb[4]; u64 gp = 0; const bool needp = (g == 0) && (u.plo > 0);
                unsigned spins = 0;
                for (;;) {
                    bool ok = true;
#pragma unroll
                    for (int i = 0; i < 4; ++i) { const int k = 4 * g + i; if (k < npre) { ga[i] = gr_load(gA + (size_t)(pos - 1 - k) * 2048); gb[i] = gr_load(gB + (size_t)(pos - 1 - k) * 2048); } else { ga[i] = 0; gb[i] = 0; } }
                    if (needp) gp = gr_load(((DIR == 1 && u.plo == 1) ? gA : gP) + (size_t)(u.plo - 1) * 2048);
#pragma unroll
                    for (int i = 0; i < 4; ++i) { const int k = 4 * g + i; if (k < npre) ok = ok && ((unsigned)(ga[i] >> 32) == epoch) && ((unsigned)(gb[i] >> 32) == epoch); }
                    if (needp) ok = ok && ((unsigned)(gp >> 32) == epoch);
                    if (ok) break;
                    __builtin_amdgcn_s_sleep(2);
                    if ((++spins & 63u) == 0u) { if (__hip_atomic_load(tmo, __ATOMIC_RELAXED, __HIP_MEMORY_SCOPE_AGENT) != 0u) break; if (spins > (1u << 16)) { __hip_atomic_store(tmo, 1u, __ATOMIC_RELAXED, __HIP_MEMORY_SCOPE_AGENT); break; } }
                }
#pragma unroll
                for (int i = 0; i < 4; ++i) { const int k = 4 * g + i; if (k < npre) { Bp = Ap * __uint_as_float((unsigned)gb[i]) + Bp; Ap = Ap * __uint_as_float((unsigned)ga[i]); } }
                if (needp) hbase = __uint_as_float((unsigned)gp);
            }
            *(LAS f32x2*)(part + (g * 128 + c) * 2) = (f32x2){Ap, Bp};
            WG_BAR();
            if (tq < 128) {
                float Aa = 1.f, Ba = 0.f;
#pragma unroll
                for (int g2 = 0; g2 < 4; ++g2) { const f32x2 p = *(const LAS f32x2*)(part + (g2 * 128 + c) * 2); Ba = Aa * p.y + Ba; Aa = Aa * p.x; }
                float h = Aa * hbase + Ba;
                gr_store(gP + (size_t)pos * 2048, epoch, At * h + Bt);
#pragma unroll
                for (int s = 0; s < 4; ++s) { const int seg = DIR == 0 ? s : 3 - s; car[seg * 128 + c] = h; h = tb[s].x * h + tb[s].y; }
            }
            WG_BAR();
#pragma unroll
            for (int ai = 0; ai < 2; ++ai) {
                const int seg = 2 * ai + wr;
                const f32x4 hs0 = *(const LAS f32x4*)(car + seg * 128 + cl), hs1 = *(const LAS f32x4*)(car + seg * 128 + cl + 4);
                constexpr int MT = DIR == 0 ? 3 : 0;
                const f32x4 one4 = (f32x4){1.f, 1.f, 1.f, 1.f}, zero4 = (f32x4){0.f, 0.f, 0.f, 0.f};
                const f32x4 pe0 = dpp4<DIR == 0 ? DPP_SHR(1) : DPP_SHL(1)>(one4, acc[ai][0][MT][0]), le0 = dpp4<DIR == 0 ? DPP_SHR(1) : DPP_SHL(1)>(zero4, acc[ai][1][MT][0]);
                const f32x4 pe1 = dpp4<DIR == 0 ? DPP_SHR(1) : DPP_SHL(1)>(one4, acc[ai][0][MT][1]), le1 = dpp4<DIR == 0 ? DPP_SHR(1) : DPP_SHL(1)>(zero4, acc[ai][1][MT][1]);
                const f32x4 hl0 = pe0 * hs0 + le0, hl1 = pe1 * hs1 + le1;
#pragma unroll
                for (int m = 0; m < 4; ++m) {
                    const unsigned r = row0 + ai * 128 + m;
                    f32x4 y0 = acc[ai][0][m][0] * (m == MT ? hs0 : hl0) + acc[ai][1][m][0], y1 = acc[ai][0][m][1] * (m == MT ? hs1 : hl1) + acc[ai][1][m][1];
                    if constexpr (DIR == 1) { y0 = (y0 + unpack4((u32x2){hfw[m].x, hfw[m].y})) * unpack4((u32x2){zw[m].x, zw[m].y}); y1 = (y1 + unpack4((u32x2){hfw[m].z, hfw[m].w})) * unpack4((u32x2){zw[m].z, zw[m].w}); }
                    const u32x2 p0 = pack4(y0), p1 = pack4(y1);
                    *(u32x4*)(BIG + (r * 2048u + 1024u + chb)) = (u32x4){p0.x, p0.y, p1.x, p1.y};
                }
                if constexpr (DIR == 1) { if (ai == 0) {
#pragma unroll
                    for (int m = 0; m < 4; ++m) { const unsigned r = row0 + 128 + m; hfw[m] = *(const u32x4*)(BIG + (r * 2048u + 1024u + chb)); zw[m] = *(const u32x4*)(SZB + (r * 1024u + chb)); } } }
            }
        }
        WG_BAR();
        return false;
    }
};

struct EpiC {
    const bf16_t* XC; const bf16_t* SZB; bf16_t* BIG;
    const float* br; const float* bi; const float* clam;
    u64* gran; unsigned epochF;
    LAS float* scr;
    __device__ __forceinline__ bool operator()(Acc& acc, const Unit& u, int wr, int wc, int fr, int fq) const {
        const int pm = u.pm, pn = u.pn;
        const int cl = 16 * wc + 4 * fq, ch0 = 64 * pn + cl;
        const unsigned row0 = (unsigned)pm * 256 + wr * 64 + fr;
        const f32x4 one4 = (f32x4){1.f, 1.f, 1.f, 1.f}, zero4 = (f32x4){0.f, 0.f, 0.f, 0.f};
        const int tq = (wr * 4 + wc) * 64 + fq * 16 + fr;
        constexpr int MODE = 1; const float cin = 0.f;
        u32x2 xw[2][4];
#pragma unroll
        for (int ai = 0; ai < 2; ++ai)
#pragma unroll
            for (int m = 0; m < 4; ++m) xw[ai][m] = *(const u32x2*)(XC + (size_t)(row0 + ai * 128 + m * 16) * 1024 + ch0);
        const float nl2e = opaque_f(-LOG2E), m1 = opaque_f(-1.0f);
#pragma unroll
        for (int d = 0; d < 2; ++d) {
            const f32x4 brv = *(const f32x4*)(br + d * 1024 + ch0) * (-LOG2E), biv = *(const f32x4*)(bi + d * 1024 + ch0) * (-LOG2E);
            const f32x4 cv = *(const f32x4*)(clam + d * 1024 + ch0) * LOG2E;
#pragma unroll
            for (int ai = 0; ai < 2; ++ai)
#pragma unroll
                for (int m = 0; m < 4; ++m) {
                    const f32x4 x = unpack4(xw[ai][m]);
                    const f32x4 tr = acc[ai][d][m][0] * nl2e + brv, ti = acc[ai][d][m][1] * nl2e + biv;
                    const f32x4 r = rcp4(exp2_4(tr) + 1.0f), pi = exp2_4(ti) + 1.0f;
                    const f32x4 a = exp2_4(cv * r);
                    const f32x4 w = (a * a) * m1 + 1.0f;
                    acc[ai][d][m][0] = a; acc[ai][d][m][1] = (w * rsq4((pi * pi) * w + 1e-30f)) * x;
                    __builtin_amdgcn_sched_barrier(0);
                }
        }
#define SCAN_STEP(SH) \
        "v_fmac_f32_dpp %0, %0, %4 " SH " row_mask:0xf bank_mask:0xf\n\tv_fmac_f32_dpp %1, %1, %5 " SH " row_mask:0xf bank_mask:0xf\n\t" \
        "v_fmac_f32_dpp %2, %2, %6 " SH " row_mask:0xf bank_mask:0xf\n\tv_fmac_f32_dpp %3, %3, %7 " SH " row_mask:0xf bank_mask:0xf\n\t" \
        "v_mul_f32_dpp %4, %4, %4 " SH " row_mask:0xf bank_mask:0xf\n\tv_mul_f32_dpp %5, %5, %5 " SH " row_mask:0xf bank_mask:0xf\n\t" \
        "v_mul_f32_dpp %6, %6, %6 " SH " row_mask:0xf bank_mask:0xf\n\tv_mul_f32_dpp %7, %7, %7 " SH " row_mask:0xf bank_mask:0xf\n\t"
#define SCAN_CARRY(BC) \
        "v_fmac_f32_dpp %0, %8, %4 " BC " row_mask:0xf bank_mask:0xf\n\tv_fmac_f32_dpp %1, %9, %5 " BC " row_mask:0xf bank_mask:0xf\n\t" \
        "v_fmac_f32_dpp %2, %10, %6 " BC " row_mask:0xf bank_mask:0xf\n\tv_fmac_f32_dpp %3, %11, %7 " BC " row_mask:0xf bank_mask:0xf\n\t" \
        "v_mul_f32_dpp %4, %12, %4 " BC " row_mask:0xf bank_mask:0xf\n\tv_mul_f32_dpp %5, %13, %5 " BC " row_mask:0xf bank_mask:0xf\n\t" \
        "v_mul_f32_dpp %6, %14, %6 " BC " row_mask:0xf bank_mask:0xf\n\tv_mul_f32_dpp %7, %15, %7 " BC " row_mask:0xf bank_mask:0xf\n\t"
#define SCAN_OUT(A, L) "+v"(L[0]), "+v"(L[1]), "+v"(L[2]), "+v"(L[3]), "+v"(A[0]), "+v"(A[1]), "+v"(A[2]), "+v"(A[3])
#define SCAN_IN(A, L) "v"(L[0]), "v"(L[1]), "v"(L[2]), "v"(L[3]), "v"(A[0]), "v"(A[1]), "v"(A[2]), "v"(A[3])
#pragma unroll
        for (int ai = 0; ai < 2; ++ai) {
            asm volatile("s_nop 1\n\t" SCAN_STEP("row_shr:1") SCAN_STEP("row_shr:2") SCAN_STEP("row_shr:4") SCAN_STEP("row_shr:8") "s_nop 1" : SCAN_OUT(acc[ai][0][0][0], acc[ai][0][0][1]));
#pragma unroll
            for (int m = 1; m < 4; ++m)
                asm volatile("s_nop 1\n\t" SCAN_STEP("row_shr:1") SCAN_STEP("row_shr:2") SCAN_STEP("row_shr:4") SCAN_STEP("row_shr:8") SCAN_CARRY("row_newbcast:15") "s_nop 1"
                             : SCAN_OUT(acc[ai][0][m][0], acc[ai][0][m][1]) : SCAN_IN(acc[ai][0][m - 1][0], acc[ai][0][m - 1][1]));
            asm volatile("s_nop 1\n\t" SCAN_STEP("row_shl:1") SCAN_STEP("row_shl:2") SCAN_STEP("row_shl:4") SCAN_STEP("row_shl:8") "s_nop 1" : SCAN_OUT(acc[ai][1][3][0], acc[ai][1][3][1]));
#pragma unroll
            for (int m = 2; m >= 0; --m)
                asm volatile("s_nop 1\n\t" SCAN_STEP("row_shl:1") SCAN_STEP("row_shl:2") SCAN_STEP("row_shl:4") SCAN_STEP("row_shl:8") SCAN_CARRY("row_newbcast:0") "s_nop 1"
                             : SCAN_OUT(acc[ai][1][m][0], acc[ai][1][m][1]) : SCAN_IN(acc[ai][1][m + 1][0], acc[ai][1][m + 1][1]));
            const int seg = 2 * ai + wr;
            if (fr == 15) {
#pragma unroll
                for (int j = 0; j < 4; ++j) *(LAS f32x2*)(scr + ((seg * 2 + 0) * 64 + cl + j) * 2) = (f32x2){acc[ai][0][3][0][j], acc[ai][0][3][1][j]};
            }
            if (fr == 0) {
#pragma unroll
                for (int j = 0; j < 4; ++j) *(LAS f32x2*)(scr + ((seg * 2 + 1) * 64 + cl + j) * 2) = (f32x2){acc[ai][1][0][0][j], acc[ai][1][0][1][j]};
            }
        }
#undef SCAN_STEP
#undef SCAN_CARRY
#undef SCAN_OUT
#undef SCAN_IN
        u32x2 zw[2][4];
        {
#pragma unroll
            for (int ai = 0; ai < 2; ++ai)
#pragma unroll
                for (int m = 0; m < 4; ++m) zw[ai][m] = *(const u32x2*)(SZB + (size_t)(row0 + ai * 128 + m * 16) * 1024 + ch0);
        }
        WG_BAR();
        {
            const int t = tq;
            LAS float* car = scr + 1024;
            if (t < 128) { const int d = t >> 6, c = t & 63;
                float h = cin;
#pragma unroll
                for (int s = 0; s < 4; ++s) { const int seg = d ? 3 - s : s; car[(seg * 2 + d) * 64 + c] = h; const f32x2 tb = *(const LAS f32x2*)(scr + ((seg * 2 + d) * 64 + c) * 2); h = tb.x * h + tb.y; }
                gr_store(gran + (d == 0 ? 2 * GR_N : 0) + (size_t)((pm - 64) * 8 + (pn >> 1)) * 128 + 64 * (pn & 1) + c, epochF + (unsigned)d, h);
            }
            {
                WG_BAR();
#pragma unroll
                for (int ai = 0; ai < 2; ++ai) {
                    const int seg = 2 * ai + wr;
                    const f32x4 hf = *(const LAS f32x4*)(car + (seg * 2 + 0) * 64 + cl), hb = *(const LAS f32x4*)(car + (seg * 2 + 1) * 64 + cl);
#pragma unroll
                    for (int m = 0; m < 4; ++m) {
                        const size_t r = row0 + ai * 128 + m * 16;
                        const f32x4 z = unpack4(zw[ai][m]);
                        const f32x4 y = (acc[ai][0][m][0] * hf + acc[ai][0][m][1]) + (acc[ai][1][m][0] * hb + acc[ai][1][m][1]);
                        *(u32x2*)(BIG + r * 2048 + 1024 + ch0) = pack4(y * z);
                    }
                }
            }
        }
        WG_BAR();
        return false;
    }
};

struct EpiG2 {
    const bf16_t* RAT; const bf16_t* SMB; bf16_t* MG; unsigned* cnt; unsigned* pcnt;
    __device__ __forceinline__ bool operator()(Acc& acc, const Unit& u, int wr, int wc, int fr, int fq) const {
        const unsigned row0 = (unsigned)u.pm * 256 + wr * 64 + fr; const unsigned col0 = 256 * u.pn + 32 * wc + 8 * fq;
        const bf16_t* src = u.kk == 0 ? RAT : SMB;
#pragma unroll
        for (int ai = 0; ai < 2; ++ai)
#pragma unroll
            for (int m = 0; m < 4; ++m) {
                if (m == 2) asm volatile("" ::: "memory");
#pragma unroll
                for (int bj = 0; bj < 2; ++bj) {
                    const unsigned off = (row0 + ai * 128 + m * 16) * 1024u + col0 + 128 * bj;
                    const u32x4 w = *(const u32x4*)(src + off);
                    acc[ai][bj][m][0] = acc[ai][bj][m][0] * unpack4((u32x2){w.x, w.y});
                    acc[ai][bj][m][1] = acc[ai][bj][m][1] * unpack4((u32x2){w.z, w.w});
                    if (u.kk == 1) { const u32x2 a = pack4(acc[ai][bj][m][0]), b = pack4(acc[ai][bj][m][1]); *(u32x4*)(MG + off) = (u32x4){a.x, a.y, b.x, b.y}; }
                }
            }
        unsigned* const pc = u.pm >= 64 ? cnt : (pcnt != nullptr ? pcnt + u.pm * 16 : nullptr);
        if (pc != nullptr && u.kk == 1) {
            asm volatile("s_waitcnt vmcnt(0)" ::: "memory"); WG_BAR();
            if (wr == 0 && wc == 0 && fq == 0 && fr == 0) { __builtin_amdgcn_fence(__ATOMIC_RELEASE, "agent"); asm volatile("s_waitcnt vmcnt(0)" ::: "memory");
                __hip_atomic_fetch_add(pc, 1u, __ATOMIC_RELAXED, __HIP_MEMORY_SCOPE_AGENT); }
        }
        return u.kk == 0;
    }
};

template <bool FINAL> struct EpiG3 {
    static constexpr bool AFTER_DRAIN = true;
    const float* xin_lat; const float* xin_ctx; float* out_lat; float* out_ctx; const float* mod;
    const float* gn; const float* modn;
    bf16_t* BIG; u64* xg; unsigned* tmo; unsigned epoch;
    LAS float* scr;
    unsigned* cnt;
    __device__ __forceinline__ void final(Acc& acc, const Unit& u, int wr, int wc, int lane, LAS unsigned char* lds) const {
        const int pm = u.pm; const bool isctx = pm >= 64; const int v = isctx ? 2 : (pm >> 5);
        const float* xin = isctx ? xin_ctx : xin_lat; float* out = isctx ? out_ctx : out_lat;
        const int fr = lane & 15, fq = lane >> 4, wave = wr * 4 + wc;
        const unsigned col = 256 * u.pn + 4 * lane;
        const unsigned rbase = (unsigned)(isctx ? pm - 64 : pm) * 256 + 16 * wave;
        const f32x4 gt = *(const f32x4*)(mod + v * 3072 + 2048 + col);
        f32x4 y[2][16]; float tot = 0.f;
#pragma unroll
        for (int h = 0; h < 2; ++h) {
#pragma unroll
            for (int bj = 0; bj < 2; ++bj)
#pragma unroll
                for (int m = 0; m < 4; ++m)
#pragma unroll
                    for (int n = 0; n < 2; ++n) { const int rowh = 64 * wr + 16 * m + fr, c16 = 32 * bj + 8 * wc + 4 * n + fq;
                        *(LAS f32x4*)(lds + rowh * 1024 + ((c16 ^ (rowh & 7)) << 4)) = acc[h][bj][m][n]; }
            WG_BAR();
#pragma unroll
            for (int rb = 0; rb < 4; ++rb) {
            f32x4 xv[4];
#pragma unroll
            for (int r8 = 0; r8 < 4; ++r8) { const float* rowp = xin + (size_t)(rbase + 128 * h + 4 * rb + r8) * 1024; xv[r8] = *(const f32x4*)(rowp + col); }
#pragma unroll
            for (int r8 = 0; r8 < 4; ++r8) { const int rr = 4 * rb + r8, rowh = 16 * wave + rr;
                const f32x4 a4 = *(const LAS f32x4*)(lds + rowh * 1024 + ((lane ^ (rowh & 7)) << 4));
                const f32x4 yy = xv[r8] + gt * a4; y[h][rr] = yy;
                if constexpr (!FINAL) { bf16_t* rowo = (bf16_t*)out + (size_t)(rbase + 128 * h + rr) * 2048; *(u32x2*)(rowo + col) = pack4(yy); }
                float ss = (yy[0] * yy[0] + yy[1] * yy[1]) + (yy[2] * yy[2] + yy[3] * yy[3]);
                ss += dppf<DPP_SHR(1)>(0.f, ss); ss += dppf<DPP_SHR(2)>(0.f, ss); ss += dppf<DPP_SHR(4)>(0.f, ss); ss += dppf<DPP_SHR(8)>(0.f, ss);
                const float rsum = (__builtin_bit_cast(float, __builtin_amdgcn_readlane(__builtin_bit_cast(int, ss), 15)) + __builtin_bit_cast(float, __builtin_amdgcn_readlane(__builtin_bit_cast(int, ss), 31)))
                                 + (__builtin_bit_cast(float, __builtin_amdgcn_readlane(__builtin_bit_cast(int, ss), 47)) + __builtin_bit_cast(float, __builtin_amdgcn_readlane(__builtin_bit_cast(int, ss), 63)));
                if (lane == 16 * h + rr) tot = rsum;
                if (r8 & 1) __builtin_amdgcn_sched_barrier(0); }
            asm volatile("" ::: "memory");
            }
            WG_BAR();
        }
        float rstd = 0.f;
        if (lane < 32) {
            const unsigned row = 128 * (lane >> 4) + 16 * wave + (lane & 15);
            u64* g = xg + ((size_t)pm * 256 + row) * 4;
            gr_store(g + u.pn, epoch, tot);
            u64 w[4]; unsigned spins = 0;
            for (;;) {
                bool ok = true;
#pragma unroll
                for (int t = 0; t < 4; ++t) { w[t] = gr_load(g + t); ok = ok && ((unsigned)(w[t] >> 32) == epoch); }
                if (ok) break;
                __builtin_amdgcn_s_sleep(2);
                if ((++spins & 63u) == 0u) { if (__hip_atomic_load(tmo, __ATOMIC_RELAXED, __HIP_MEMORY_SCOPE_AGENT) != 0u) break; if (spins > (1u << 16)) { __hip_atomic_store(tmo, 1u, __ATOMIC_RELAXED, __HIP_MEMORY_SCOPE_AGENT); break; } }
            }
            const float t4 = (__uint_as_float((unsigned)w[0]) + __uint_as_float((unsigned)w[1])) + (__uint_as_float((unsigned)w[2]) + __uint_as_float((unsigned)w[3]));
            rstd = rsqrtf(t4 * (1.0f / 1024.0f) + RMS_EPS);
        }
        f32x4 gs = *(const f32x4*)(gn + col), sh = (f32x4){0.f, 0.f, 0.f, 0.f};
        if constexpr (!FINAL) { gs = gs * (*(const f32x4*)(modn + v * 3072 + 1024 + col) + 1.0f); sh = *(const f32x4*)(modn + v * 3072 + col); }
        const unsigned hbase = (unsigned)pm * 256 + 16 * wave;
#pragma unroll
        for (int h = 0; h < 2; ++h)
#pragma unroll
            for (int rr = 0; rr < 16; ++rr) {
                const float rs = __builtin_bit_cast(float, __builtin_amdgcn_readlane(__builtin_bit_cast(int, rstd), 16 * h + rr));
                if constexpr (FINAL) { float* rowo = out + (size_t)(rbase + 128 * h + rr) * 1024; *(f32x4*)(rowo + col) = y[h][rr] * rs * gs; }
                else { bf16_t* rowh_ = BIG + (size_t)(hbase + 128 * h + rr) * 2048 + 1024; *(u32x2*)(rowh_ + col) = pack4(y[h][rr] * rs * gs + sh); }
            }
        if (cnt != nullptr && isctx) {
            asm volatile("s_waitcnt vmcnt(0)" ::: "memory"); WG_BAR();
            if (wave == 0 && lane == 0) { __builtin_amdgcn_fence(__ATOMIC_RELEASE, "agent"); asm volatile("s_waitcnt vmcnt(0)" ::: "memory");
                __hip_atomic_fetch_add(cnt, 1u, __ATOMIC_RELAXED, __HIP_MEMORY_SCOPE_AGENT); }
        }
    }
};

template <bool FINAL> struct EpiG3old {
    const float* xin_lat; const float* xin_ctx; float* out_lat; float* out_ctx; const float* mod;
    const float* gn; const float* modn;
    bf16_t* BIG; u64* xg; unsigned* tmo; unsigned epoch;
    LAS float* scr;
    unsigned* cnt;
    __device__ __forceinline__ bool operator()(Acc& acc, const Unit& u, int wr, int wc, int fr, int fq) const {
        const int pm = u.pm; const bool isctx = pm >= 64; const int v = isctx ? 2 : (pm >> 5);
        const float* xin = isctx ? xin_ctx : xin_lat; float* out = isctx ? out_ctx : out_lat;
        const size_t row0 = (size_t)(isctx ? pm - 64 : pm) * 256 + wr * 64 + fr; const int col0 = 256 * u.pn + 32 * wc + 4 * fq;
        const int tq = (wr * 4 + wc) * 64 + fq * 16 + fr, lane = fq * 16 + fr;
        {
            f32x4 gt[2][2];
#pragma unroll
            for (int bj = 0; bj < 2; ++bj)
#pragma unroll
                for (int n = 0; n < 2; ++n) gt[bj][n] = *(const f32x4*)(mod + v * 3072 + 2048 + col0 + 128 * bj + 16 * n);
#pragma unroll
            for (int ai = 0; ai < 2; ++ai)
#pragma unroll
                for (int m = 0; m < 4; ++m) {
                    float ss = 0.f;
#pragma unroll
                    for (int bj = 0; bj < 2; ++bj)
#pragma unroll
                        for (int n = 0; n < 2; ++n) { const size_t off = (row0 + ai * 128 + m * 16) * 1024 + col0 + 128 * bj + 16 * n;
                            f32x4 xr; if constexpr (FINAL) xr = unpack4(*(const u32x2*)((const bf16_t*)xin + off + (row0 + ai * 128 + m * 16) * 1024)); else xr = *(const f32x4*)(xin + off);
                            const f32x4 y = xr + gt[bj][n] * acc[ai][bj][m][n]; acc[ai][bj][m][n] = y;
                            if constexpr (!FINAL) *(f32x4*)(out + off) = y;
                            ss += (y[0] * y[0] + y[1] * y[1]) + (y[2] * y[2] + y[3] * y[3]); }
                    ss += __builtin_bit_cast(float, __builtin_amdgcn_ds_bpermute((lane ^ 16) << 2, __builtin_bit_cast(int, ss)));
                    ss += __builtin_bit_cast(float, __builtin_amdgcn_ds_bpermute((lane ^ 32) << 2, __builtin_bit_cast(int, ss)));
                    if (fq == 0) scr[(ai * 128 + wr * 64 + m * 16 + fr) * 4 + wc] = ss;
                    if (m & 1) asm volatile("" ::: "memory");
                }
        }
        WG_BAR();
        if (tq < 256) {
            const f32x4 p = *(const LAS f32x4*)(scr + tq * 4);
            u64* g = xg + ((size_t)pm * 256 + tq) * 4;
            gr_store(g + u.pn, epoch, (p[0] + p[1]) + (p[2] + p[3]));
            u64 w[4]; unsigned spins = 0;
            for (;;) {
                bool ok = true;
#pragma unroll
                for (int t = 0; t < 4; ++t) { w[t] = gr_load(g + t); ok = ok && ((unsigned)(w[t] >> 32) == epoch); }
                if (ok) break;
                __builtin_amdgcn_s_sleep(2);
                if ((++spins & 63u) == 0u) { if (__hip_atomic_load(tmo, __ATOMIC_RELAXED, __HIP_MEMORY_SCOPE_AGENT) != 0u) break; if (spins > (1u << 16)) { __hip_atomic_store(tmo, 1u, __ATOMIC_RELAXED, __HIP_MEMORY_SCOPE_AGENT); break; } }
            }
            const float tot = (__uint_as_float((unsigned)w[0]) + __uint_as_float((unsigned)w[1])) + (__uint_as_float((unsigned)w[2]) + __uint_as_float((unsigned)w[3]));
            scr[1024 + tq] = rsqrtf(tot * (1.0f / 1024.0f) + RMS_EPS);
        }
        WG_BAR();
        {
            f32x4 gs[2][2], sh[2][2];
#pragma unroll
            for (int bj = 0; bj < 2; ++bj)
#pragma unroll
                for (int n = 0; n < 2; ++n) { const int c = col0 + 128 * bj + 16 * n; gs[bj][n] = *(const f32x4*)(gn + c);
                    if constexpr (!FINAL) { gs[bj][n] = gs[bj][n] * (*(const f32x4*)(modn + v * 3072 + 1024 + c) + 1.0f); sh[bj][n] = *(const f32x4*)(modn + v * 3072 + c); } }
            const size_t hrow0 = (size_t)pm * 256 + wr * 64 + fr;
#pragma unroll
            for (int ai = 0; ai < 2; ++ai)
#pragma unroll
                for (int m = 0; m < 4; ++m) {
                    const float rstd = scr[1024 + ai * 128 + wr * 64 + m * 16 + fr];
#pragma unroll
                    for (int bj = 0; bj < 2; ++bj)
#pragma unroll
                        for (int n = 0; n < 2; ++n) { const int c = col0 + 128 * bj + 16 * n;
                            if constexpr (FINAL) *(f32x4*)(out + (row0 + ai * 128 + m * 16) * 1024 + c) = acc[ai][bj][m][n] * rstd * gs[bj][n];
                            else *(u32x2*)(BIG + (hrow0 + ai * 128 + m * 16) * 2048 + 1024 + c) = pack4(acc[ai][bj][m][n] * rstd * gs[bj][n] + sh[bj][n]); }
                }
        }
        if (cnt != nullptr && isctx) asm volatile("s_waitcnt vmcnt(0)" ::: "memory");
        WG_BAR();
        if (cnt != nullptr && isctx && tq == 0) { __builtin_amdgcn_fence(__ATOMIC_RELEASE, "agent"); asm volatile("s_waitcnt vmcnt(0)" ::: "memory");
            __hip_atomic_fetch_add(cnt, 1u, __ATOMIC_RELAXED, __HIP_MEMORY_SCOPE_AGENT); }
        return false;
    }
};

#define XB_TMO      128
#define XB_XCNT(j)  (256  + 64 * (j))
#define XB_XSUB(j)  (1280 + 64 * (j))
#define XB_XGEN(j)  (2304 + 64 * (j))
#define XB_TOP      3328
#define XB_TOPGEN   3392
#define XCD_BAR_WORDS 3456
#define XB_SPIN_CAP (1u << 18)
__device__ __forceinline__ unsigned xb_ld(unsigned* p)              { return __hip_atomic_load(p, __ATOMIC_RELAXED, __HIP_MEMORY_SCOPE_AGENT); }
__device__ __forceinline__ unsigned xb_add(unsigned* p, unsigned v) { return __hip_atomic_fetch_add(p, v, __ATOMIC_RELAXED, __HIP_MEMORY_SCOPE_AGENT); }
__device__ __forceinline__ unsigned xb_xcc_id() { return (unsigned)__builtin_amdgcn_s_getreg((3 << 11) | 20) & 0xFu; }
#define XB_SPIN(cond, bar) do { unsigned _sp = 0; while (cond) { __builtin_amdgcn_s_sleep(1); \
    if ((++_sp & 255u) == 0u) { if (xb_ld(&(bar)[XB_TMO])) break; if (_sp > XB_SPIN_CAP) { atomicAdd(&(bar)[XB_TMO], 1u); break; } } } } while (0)
struct XcdBarrier { unsigned* bar; unsigned x; volatile LAS unsigned* st; };
__device__ __forceinline__ XcdBarrier xcd_barrier_post(unsigned* bar, volatile LAS unsigned* st) {
    XcdBarrier b; b.bar = bar; b.x = xb_xcc_id(); b.st = st;
    if (threadIdx.x == 0) (void)xb_add(&bar[XB_XCNT(b.x)], 1u);
    return b;
}
__device__ __forceinline__ void xcd_barrier_complete(unsigned* bar, unsigned x, unsigned& nloc, unsigned& nx) {
    const unsigned G = gridDim.x * gridDim.y * gridDim.z;
    unsigned sum, cnt, mine, sp = 0u;
    for (;;) {
        sum = 0u; cnt = 0u; mine = 0u;
#pragma unroll
        for (unsigned j = 0; j < 16; ++j) { const unsigned c = xb_ld(&bar[XB_XCNT(j)]); sum += c; cnt += (c > 0u) ? 1u : 0u; mine = (j == x) ? c : mine; }
        if (sum == G) break;
        __builtin_amdgcn_s_sleep(1);
        if ((++sp & 255u) == 0u) { if (xb_ld(&bar[XB_TMO])) break; if (sp > XB_SPIN_CAP) { atomicAdd(&bar[XB_TMO], 1u); break; } }
    }
    nloc = mine > 0u ? mine : 1u; nx = cnt > 0u ? cnt : 1u;
}
__device__ __forceinline__ void xcd_barrier(const XcdBarrier& b, bool leader) {
    asm volatile("s_waitcnt vmcnt(0)" ::: "memory");
    __syncthreads();
    if (leader) {
        unsigned* bar = b.bar;
        __builtin_amdgcn_s_waitcnt(0);
        unsigned nloc = b.st[0], nx = b.st[1];
        if (nloc == 0u) { xcd_barrier_complete(bar, b.x, nloc, nx); b.st[0] = nloc; b.st[1] = nx; }
        const unsigned old = xb_add(&bar[XB_XSUB(b.x)], 1u);
        const unsigned gen = old / nloc;
        if (old + 1u == (gen + 1u) * nloc) {
            __builtin_amdgcn_fence(__ATOMIC_RELEASE, "agent");
            asm volatile("s_waitcnt vmcnt(0)" ::: "memory");
            const unsigned og = xb_add(&bar[XB_TOP], 1u);
            const unsigned tg = og / nx;
            if (og + 1u == (tg + 1u) * nx) xb_add(&bar[XB_TOPGEN], 1u);
            else XB_SPIN(xb_ld(&bar[XB_TOPGEN]) == tg, bar);
            __builtin_amdgcn_fence(__ATOMIC_ACQUIRE, "agent");
            xb_add(&bar[XB_XGEN(b.x)], 1u);
            asm volatile("s_waitcnt vmcnt(0)" ::: "memory");
        } else {
            XB_SPIN(xb_ld(&bar[XB_XGEN(b.x)]) == gen, bar);
            __builtin_amdgcn_fence(__ATOMIC_ACQUIRE, "agent");
            asm volatile("s_waitcnt vmcnt(0)" ::: "memory");
        }
    }
    __syncthreads();
}

struct Args { const float* in[20]; float* out; unsigned char* ws; int ph_lo, ph_hi; };
typedef __attribute__((address_space(4))) const Args CArgs;
struct InTab { CArgs* ka; __device__ __forceinline__ const float* operator[](int i) const { return ka->in[i]; } };
struct Frame {
    LAS unsigned char* lds; int tid, lane, wave, vcu, G, bx;
    InTab in; float* out; unsigned char* ws;
    __device__ __forceinline__ void ids() { const int l = fresh_lane(); lane = l; tid = wave * 64 + l; }
};
__device__ __forceinline__ int opaque_v(int x) { asm volatile("" : "+v"(x)); return x; }
__device__ __forceinline__ unsigned opaque_s(unsigned x) { asm volatile("" : "+s"(x)); return x; }
__device__ __forceinline__ float wave_sum(float v, int lane) {
#pragma unroll
    for (int o = 1; o < 64; o <<= 1) v += __builtin_bit_cast(float, __builtin_amdgcn_ds_bpermute((lane ^ o) << 2, __builtin_bit_cast(int, v)));
    return v;
}

__device__ __forceinline__ int w1_dest_row(int s) {
    const int chunk = s >> 10, ch = s & 1023;
    if (chunk < 4) { const int g = chunk == 0 ? 0 : (chunk == 1 ? 2 : (chunk == 2 ? 1 : 3)); return 256 * (ch >> 6) + 128 * (g >> 1) + 32 * ((ch >> 4) & 3) + 16 * (g & 1) + (ch & 15); }
    if (chunk < 6) { const int pn = (chunk == 4 ? 16 : 20) + (ch >> 8), r = ch & 255; return 256 * pn + 128 * (r >> 7) + 32 * ((r >> 5) & 3) + 16 * ((r >> 2) & 1) + 4 * ((r >> 3) & 3) + (r & 3); }
    { const int pn = 24 + (ch >> 7), r = ch & 127; return 256 * pn + 128 * (chunk - 6) + 32 * (r >> 5) + 16 * ((r >> 2) & 1) + 4 * ((r >> 3) & 3) + (r & 3); }
}
__device__ __forceinline__ int perm8_dest_row(int o) { return (o & ~31) | (((o >> 2) & 1) << 4) | (((o >> 3) & 3) << 2) | (o & 3); }
template <int MODE> __device__ __forceinline__ void tr_item(const float* W, int ldsrc, int k0, int n0, bf16_t* dst, int lddst, int dcol0, int p0, LAS float* scr, int lane) {
#pragma unroll 8
    for (int i = 0; i < 32; ++i) { const int kk = 2 * i + (lane >> 5); scr[kk * 33 + (lane & 31)] = W[(size_t)(k0 + kk) * ldsrc + n0 + (lane & 31)]; }
    LDS_WAIT(); asm volatile("" ::: "memory");
    const int c = lane & 7;
#pragma unroll
    for (int j = 0; j < 4; ++j) { const int n = (lane >> 3) + 8 * j; const LAS float* s = scr + (8 * c) * 33 + n;
        u32x4 o; o.x = cvt_pk_bf16(s[0 * 33], s[1 * 33]); o.y = cvt_pk_bf16(s[2 * 33], s[3 * 33]); o.z = cvt_pk_bf16(s[4 * 33], s[5 * 33]); o.w = cvt_pk_bf16(s[6 * 33], s[7 * 33]);
        const int sn = n0 + n; int drow;
        if (MODE == 0) drow = w1_dest_row(sn);
        else if (MODE == 1) drow = perm8_dest_row(sn);
        else if (MODE == 2) drow = sn;
        else if (MODE == 3) drow = p0 + 32 * (sn >> 5) + 16 * ((sn >> 2) & 1) + 4 * ((sn >> 3) & 3) + (sn & 3);
        else drow = p0 + 256 * (sn >> 6) + 32 * ((sn >> 4) & 3) + (sn & 15);
        *(u32x4*)(dst + (size_t)drow * lddst + dcol0 + k0 + 8 * c) = o; }
    LDS_WAIT(); asm volatile("" ::: "memory");
}
__device__ __forceinline__ void convert_layer(Frame& F, int l, int gw, int nw) {
    F.ids();
    LAS float* scr = (LAS float*)(F.lds + F.wave * 16384);
    for (int it = gw; it < 4096 + 1536 + 512; it += nw) {
        if (it < 4096) { const int kb = it >> 8, nb = it & 255;
            tr_item<0>(F.in[7] + (size_t)l * 1024 * 8192, 8192, 64 * kb, 32 * nb, (bf16_t*)(F.ws + WS_W1T) + (size_t)l * 8192 * 1024, 1024, 0, 0, scr, F.lane); }
        else if (it < 4096 + 1536) { int r = it - 4096; const int which = r / 512; r %= 512; const int kb = r >> 5, nb = r & 31;
            if (which == 0) tr_item<1>(F.in[16] + (size_t)l * 1024 * 1024, 1024, 64 * kb, 32 * nb, (bf16_t*)(F.ws + WS_WABT) + (size_t)l * 1024 * 2048, 2048, 0, 0, scr, F.lane);
            else if (which == 1) tr_item<1>(F.in[17] + (size_t)l * 1024 * 1024, 1024, 64 * kb, 32 * nb, (bf16_t*)(F.ws + WS_WABT) + (size_t)l * 1024 * 2048, 2048, 1024, 0, scr, F.lane);
            else tr_item<2>(F.in[18] + (size_t)l * 1024 * 1024, 1024, 64 * kb, 32 * nb, (bf16_t*)(F.ws + WS_WOT) + (size_t)l * 1024 * 1024, 1024, 0, 0, scr, F.lane); }
        else { int r = it - 4096 - 1536; const bool ctxl = r >= 256; if (ctxl) r -= 256; const int mat = r >> 3; r &= 7; const int kb = r >> 2, nb = r & 3; const int dir = (mat >> 4) & 1, isI = (mat >> 3) & 1, blk = mat & 7;
            const float* W = (isI ? F.in[13] : F.in[11]) + (size_t)((l * 2 + dir) * 8 + blk) * 128 * 128;
            if (!ctxl) tr_item<3>(W, 128, 64 * kb, 32 * nb, (bf16_t*)(F.ws + WS_GWT) + (size_t)l * 4096 * 128, 128, 0, (dir * 8 + blk) * 256 + 128 * isI, scr, F.lane);
            else tr_item<4>(W, 128, 64 * kb, 32 * nb, (bf16_t*)(F.ws + WS_GWTC) + (size_t)l * 4096 * 128, 128, 0, 512 * blk + 128 * dir + 16 * isI, scr, F.lane); }
    }
}
__device__ __forceinline__ void p0_prologue(Frame& F) {
    F.ids();
    const float* c = F.in[1]; const float* c_ctx = F.in[3]; const float* w_ada = F.in[4]; const float* b_ada = F.in[5];
    float* MOD = (float*)(F.ws + WS_MOD);
    if (F.bx < 192) {
        LAS float* sc = (LAS float*)F.lds;
        LAS float* red = sc + 3072;
        for (int i = F.tid; i < 3072; i += 512) { const float x = i < 2048 ? c[i] : c_ctx[i - 2048]; sc[i] = x * sigmoidf_(x); }
        __syncthreads();
        for (int u = F.bx; u < 192; u += F.G) {
            const int l = u / 96, cl = F.lane & 31, col = (u % 96) * 32 + cl, k0 = F.wave * 128 + (F.lane >> 5);
            const float* W = w_ada + (size_t)l * 1024 * 3072 + col;
            float a0 = 0.f, a1 = 0.f, a2 = 0.f;
#pragma unroll 16
            for (int kk = 0; kk < 64; ++kk) { const int k = k0 + 2 * kk; const float w = W[(size_t)k * 3072]; a0 += sc[k] * w; a1 += sc[1024 + k] * w; a2 += sc[2048 + k] * w; }
            a0 += __builtin_bit_cast(float, __builtin_amdgcn_ds_bpermute((F.lane ^ 32) << 2, __builtin_bit_cast(int, a0)));
            a1 += __builtin_bit_cast(float, __builtin_amdgcn_ds_bpermute((F.lane ^ 32) << 2, __builtin_bit_cast(int, a1)));
            a2 += __builtin_bit_cast(float, __builtin_amdgcn_ds_bpermute((F.lane ^ 32) << 2, __builtin_bit_cast(int, a2)));
            if (F.lane < 32) { red[(F.wave * 3 + 0) * 32 + cl] = a0; red[(F.wave * 3 + 1) * 32 + cl] = a1; red[(F.wave * 3 + 2) * 32 + cl] = a2; }
            __syncthreads();
            if (F.tid < 96) { const int v = F.tid >> 5, c2 = F.tid & 31; float s = 0.f;
#pragma unroll
                for (int w = 0; w < 8; ++w) s += red[(w * 3 + v) * 32 + c2];
                const int colo = (u % 96) * 32 + c2; MOD[(l * 3 + v) * 3072 + colo] = s + b_ada[l * 3072 + colo]; }
            __syncthreads();
        }
    }
    __syncthreads();
    { const int gi = F.bx * 512 + F.tid; if (gi < NL * 2 * 1024) { const float e = __builtin_amdgcn_exp2f(-F.in[15][gi] * LOG2E);
            ((float*)(F.ws + WS_CLAM))[gi] = -8.0f * (e * (1.0f + e * (-0.5f + e * (0.33333334f + e * (-0.25f + e * 0.2f))))); } }
    convert_layer(F, 0, F.vcu * NWAVES + F.wave, F.G * NWAVES);
}

__device__ __forceinline__ void norm_phase(Frame& F, int l, bool final) {
    F.ids();
    const int gw = F.vcu * NWAVES + F.wave, NGW = F.G * NWAVES;
    const float* MOD = (const float*)(F.ws + WS_MOD) + (size_t)l * 3 * 3072;
    const float* gsrc = final ? F.in[19] : F.in[6] + l * 1024;
    bf16_t* BIG = (bf16_t*)(F.ws + WS_BIG);
    const int nrows = final ? ML : M;
    f32x4 g4[4];
#pragma unroll
    for (int j = 0; j < 4; ++j) g4[j] = *(const f32x4*)(gsrc + 4 * F.lane + 256 * j);
    for (int row = gw; row < nrows; row += NGW) {
        const bool isctx = row >= ML;
        const float* src = (l == 0 && !final) ? (isctx ? F.in[2] + (size_t)(row - ML) * 1024 : F.in[0] + (size_t)row * 1024)
                                              : (isctx ? (const float*)(F.ws + WS_CTX1) + (size_t)(row - ML) * 1024 : F.out + (size_t)row * 1024);
        f32x4 v[4]; float ss = 0.f;
#pragma unroll
        for (int j = 0; j < 4; ++j) { v[j] = *(const f32x4*)(src + 4 * F.lane + 256 * j); ss += (v[j][0] * v[j][0] + v[j][1] * v[j][1]) + (v[j][2] * v[j][2] + v[j][3] * v[j][3]); }
        const float rstd = rsqrtf(wave_sum(ss, F.lane) * (1.0f / 1024.0f) + RMS_EPS);
        if (final) {
#pragma unroll
            for (int j = 0; j < 4; ++j) *(f32x4*)(F.out + (size_t)row * 1024 + 4 * F.lane + 256 * j) = v[j] * rstd * g4[j];
        } else {
            const int vi = isctx ? 2 : (row >> 13);
            const float* sh = MOD + vi * 3072; const float* scl = sh + 1024;
#pragma unroll
            for (int j = 0; j < 4; ++j) { const int cidx = 4 * F.lane + 256 * j;
                const f32x4 y = v[j] * rstd * g4[j]; const f32x4 h = y * (*(const f32x4*)(scl + cidx) + 1.0f) + *(const f32x4*)(sh + cidx);
                *(u32x2*)(BIG + (size_t)row * 2048 + 1024 + cidx) = pack4(h); }
        }
    }
}

__device__ __forceinline__ void panel_wait(const pg8::Sched& S, unsigned* pc, int wave) {
    asm volatile("" : "+s"(wave));
    if (wave == 0) {
        pg8::Unit u0;
        for (int i = 0; S.next(i, u0); ++i) { unsigned spins = 0;
            while (__hip_atomic_load(pc + u0.pm * 16, __ATOMIC_RELAXED, __HIP_MEMORY_SCOPE_AGENT) < 4u) { __builtin_amdgcn_s_sleep(2); if (++spins > (1u << 20)) break; } }
        __builtin_amdgcn_fence(__ATOMIC_ACQUIRE, "agent"); asm volatile("s_waitcnt vmcnt(0)" ::: "memory");
    }
    __syncthreads();
}

constexpr int N_PHASES = 12;
__global__ void __launch_bounds__(NWAVES * 64, 2) mk_fwd(Args args) {
    extern __shared__ __attribute__((aligned(16))) unsigned char lds[];
    const int wave_id = __builtin_amdgcn_readfirstlane((int)threadIdx.x >> 6);
    volatile LAS unsigned* MISC = (volatile LAS unsigned*)((LAS unsigned char*)lds + MISC_OFF);
    for (int u = threadIdx.x; u < 128; u += NWAVES * 64) MISC[u] = 0u;
    __syncthreads();
    XcdBarrier bar; bar.bar = (unsigned*)(args.ws + WS_CTL) + CW_BAR; bar.x = 0; bar.st = nullptr;
    if (!MK_PER_PHASE) bar = xcd_barrier_post((unsigned*)(args.ws + WS_CTL) + CW_BAR, MISC + 8);

    for (int it = 2 * args.ph_lo; it < 2 * args.ph_hi; ++it) {
        const int ph = it >> 1;
        if (it & 1) {
            const int kind = ph == 0 ? 7 : (ph == 1 ? 0 : 1 + (ph - 2) % 5);
            if (!((DUP_MASK >> kind) & 1) || kind == 5 || kind == 3) continue;
        }
        CArgs* ka = (CArgs*)__builtin_amdgcn_kernarg_segment_ptr(); asm volatile("" : "+s"(ka));
        Frame F;
        F.lds = (LAS unsigned char*)lds;
        F.wave = wave_id; F.lane = 0; F.tid = 0;
        int bx_ = blockIdx.x, G_ = gridDim.x; asm volatile("" : "+s"(bx_), "+s"(G_));
        F.G = G_; F.bx = bx_; F.vcu = (F.G % 8 == 0) ? (bx_ % 8) * (F.G / 8) + bx_ / 8 : bx_;
        F.in.ka = ka; F.out = ka->out; F.ws = ka->ws;
        LAS float* scr = (LAS float*)(F.lds + SCR_OFF);
        bf16_t* BIG = (bf16_t*)(F.ws + WS_BIG); bf16_t* XC = (bf16_t*)(F.ws + WS_XC); bf16_t* SZB = (bf16_t*)(F.ws + WS_SZB); bf16_t* RAT = (bf16_t*)(F.ws + WS_RAT); bf16_t* SMB = (bf16_t*)(F.ws + WS_SMB);
        float* CTX1 = (float*)(F.ws + WS_CTX1);
        if (ph == 0) { p0_prologue(F); }
        else if (ph == 1) { norm_phase(F, 0, false); }
        else {
            const int l = (ph - 2) / 5, sub = 1 + (ph - 2) % 5;
            if (sub == 1) {
                pg8::Gemm g{BIG + 1024, (const bf16_t*)(F.ws + WS_W1T) + (size_t)l * 8192 * 1024, 2048, 1024, 1024, 0, 0, 0, 0, 1};
                unsigned* ctxcnt = (unsigned*)(F.ws + WS_CTL) + CW_CTXCNT + 64 * l;
                if (l == 1 && F.bx < 8) {
                    unsigned* c2 = (unsigned*)(F.ws + WS_CTL) + CW_CG2CNT; unsigned* c3 = (unsigned*)(F.ws + WS_CTL) + CW_CG3CNT;
                    const float* MODp = (const float*)(F.ws + WS_MOD);
                    {   pg8::Gemm ga{BIG, (const bf16_t*)(F.ws + WS_WABT), 2048, 2048, 1024, 1024, 1024, 0, 0};
                        pg8::Sched Sa; Sa.init(0, 4, F.G, F.bx, 2, 8, 64, 0, 4); Sa.list_off = 0;
                        EpiG2 Ea{RAT, SMB, XC, c2, nullptr};
                        pg8::gemm_phase<EpiG2>(F.lds, ga, Sa, Ea, F.wave); }
                    if (F.wave == 0) { unsigned spins = 0; while (__hip_atomic_load(c2, __ATOMIC_RELAXED, __HIP_MEMORY_SCOPE_AGENT) < 8u) { __builtin_amdgcn_s_sleep(4); if (++spins > (1u << 20)) break; }
                        __builtin_amdgcn_fence(__ATOMIC_ACQUIRE, "agent"); asm volatile("s_waitcnt vmcnt(0)" ::: "memory"); }
                    __syncthreads();
                    {   pg8::Gemm gb{XC, (const bf16_t*)(F.ws + WS_WOT), 1024, 1024, 1024, 0, 0, 0, 0};
                        pg8::Sched Sb; Sb.init(0, 4, F.G, F.bx, 1, 8, 64, 0, 4); Sb.list_off = 0;
                        EpiG3old<false> Eb{F.in[0], F.in[2], F.out, CTX1, MODp, F.in[6] + 1024, MODp + 3 * 3072, BIG, (u64*)(F.ws + WS_GRAN) + 3 * GR_N, (unsigned*)(F.ws + WS_CTL) + CW_PTMO, opaque_s(1u), scr, c3};
                        pg8::gemm_phase<EpiG3old<false>>(F.lds, gb, Sb, Eb, F.wave); }
                    if (F.wave == 0) { unsigned spins = 0; while (__hip_atomic_load(c3, __ATOMIC_RELAXED, __HIP_MEMORY_SCOPE_AGENT) < 8u) { __builtin_amdgcn_s_sleep(4); if (++spins > (1u << 20)) break; }
                        __builtin_amdgcn_fence(__ATOMIC_ACQUIRE, "agent"); asm volatile("s_waitcnt vmcnt(0)" ::: "memory"); }
                    __syncthreads();
                }
                {
                    pg8::Sched S; if (l == 0) { S.init(64, 32, F.G, F.bx, 1, 64, 64, 0, 32); S.extra_first = 1; } else { S.init(64, 32, F.G, F.bx); S.late_n = 8; S.late_r = 7; }
                    EpiG1 E{BIG, XC, SZB, RAT, SMB, F.in[8] + l * 3 * 1024, F.in[9] + l * 4 * 1024, F.in[10] + l * 1024, scr, ctxcnt};
                    pg8::gemm_phase<EpiG1>(F.lds, g, S, E, F.wave);
                }
                {
                    pg8::Sched S2; S2.init(0, 1, F.G, F.bx, 1, 32, 64, 0, 16); S2.list_off = 64 % F.G;
                    pg8::Unit u0;
                    if (S2.next(0, u0) || S2.next(1, u0)) {
                        if (F.wave == 0) {
                            const unsigned want = l == 0 ? 64u : 8u; unsigned spins = 0;
                            while (__hip_atomic_load(ctxcnt, __ATOMIC_RELAXED, __HIP_MEMORY_SCOPE_AGENT) < want) { __builtin_amdgcn_s_sleep(4); if (++spins > (1u << 20)) break; }
                            __builtin_amdgcn_fence(__ATOMIC_ACQUIRE, "agent"); asm volatile("s_waitcnt vmcnt(0)" ::: "memory");
                        }
                        __syncthreads();
                        pg8::Gemm g2{XC, (const bf16_t*)(F.ws + WS_GWTC) + (size_t)l * 4096 * 128, 1024, 128, 128, 0, 0, 1, 128};
                        EpiC E2{XC, SZB, BIG, F.in[12] + l * 2048, F.in[14] + l * 2048, (const float*)(F.ws + WS_CLAM) + l * 2048, (u64*)(F.ws + WS_GRAN), (unsigned)(l * 2 + 1), scr};
                        pg8::gemm_phase<EpiC>(F.lds, g2, S2, E2, F.wave);
                    }
                }
                if (l == 0) {
                    const int first = F.G > 96 ? 96 : 0;
                    if (F.bx >= first) { __syncthreads(); convert_layer(F, 1, (F.bx - first) * NWAVES + F.wave, (F.G - first) * NWAVES); }
                }
            } else if (sub == 2 || sub == 3) {
                const int dir = sub - 2;
                pg8::Gemm g{XC, (const bf16_t*)(F.ws + WS_GWT) + (size_t)l * 4096 * 128 + (size_t)dir * 2048 * 128, 1024, 128, 128, 0, 0, 0, 128};
                pg8::Sched S; S.init_pass(F.G, F.bx, dir);
                unsigned* tmo = (unsigned*)(F.ws + WS_CTL) + CW_PTMO;
                if (dir == 0) { EpiP<0> E{XC, SZB, BIG, F.in[12] + l * 2048, F.in[14] + l * 2048, (const float*)(F.ws + WS_CLAM) + l * 2048, (u64*)(F.ws + WS_GRAN), tmo, (unsigned)(l * 2 + 1), scr, F.lds};
                    pg8::pass_phase<EpiP<0>>(F.lds, g, S, E, F.wave); }
                else { EpiP<1> E{XC, SZB, BIG, F.in[12] + l * 2048 + 1024, F.in[14] + l * 2048 + 1024, (const float*)(F.ws + WS_CLAM) + l * 2048 + 1024, (u64*)(F.ws + WS_GRAN), tmo, (unsigned)(l * 2 + 2), scr, F.lds};
                    pg8::pass_phase<EpiP<1>>(F.lds, g, S, E, F.wave); }
            }
            else if (sub == 4) {
                pg8::Gemm g{BIG, (const bf16_t*)(F.ws + WS_WABT) + (size_t)l * 1024 * 2048, 2048, 2048, 1024, 1024, 1024, 0, 0};
                pg8::Sched S; S.init(64, 4, F.G, F.bx, 2); S.wgm = WGM_G23;
                EpiG2 E{RAT, SMB, XC, nullptr, (unsigned*)(F.ws + WS_CTL) + CW_PANCNT + l * 1024};
                pg8::gemm_phase<EpiG2>(F.lds, g, S, E, F.wave);
            } else {
                pg8::Gemm g{XC, (const bf16_t*)(F.ws + WS_WOT) + (size_t)l * 1024 * 1024, 1024, 1024, 1024, 0, 0, 0, 0};
                unsigned* tmo = (unsigned*)(F.ws + WS_CTL) + CW_PTMO; u64* xg = (u64*)(F.ws + WS_GRAN) + 3 * GR_N;
                const float* MODp = (const float*)(F.ws + WS_MOD);
                if (l == 0) {
                    EpiG3<false> E{F.in[0], F.in[2], F.out, CTX1, MODp, F.in[6] + 1024, MODp + 3 * 3072, BIG, xg, tmo, opaque_s(1u), scr, nullptr};
                    pg8::Sched S; S.init(64, 4, F.G, F.bx); S.wgm = WGM_G23;
                    panel_wait(S, (unsigned*)(F.ws + WS_CTL) + CW_PANCNT + l * 1024, F.wave);
                    pg8::gemm_phase<EpiG3<false>>(F.lds, g, S, E, F.wave);
                } else {
                    EpiG3old<true> E{F.out, CTX1, F.out, CTX1, MODp + 3 * 3072, F.in[19], MODp, BIG, xg, tmo, opaque_s(2u), scr, nullptr};
                    pg8::Sched S; S.init(64, 4, F.G, F.bx); S.wgm = WGM_G23;
                    panel_wait(S, (unsigned*)(F.ws + WS_CTL) + CW_PANCNT + l * 1024, F.wave);
                    pg8::gemm_phase<EpiG3old<true>>(F.lds, g, S, E, F.wave);
                }
            }
        }
        if (it < 2 * args.ph_hi - 2 && !(ph >= 2 && (ph - 2) % 5 == 3 && !MK_PER_PHASE)) { const int ln2 = fresh_lane(); xcd_barrier(bar, wave_id == 0 && ln2 == 0); }
#if EXTRA_BARS
        if (ph == 4) { for (int eb = 0; eb < EXTRA_BARS; ++eb) { const int ln3 = fresh_lane(); xcd_barrier(bar, wave_id == 0 && ln3 == 0); } }
#endif
    }
}

extern "C" void kernel_launch(void* const* d_in, const int* in_sizes, int n_in, void* d_out, int out_size, void* d_ws, size_t ws_size, hipStream_t stream) {
    static int grid = 0;
    if (grid == 0) {
        if (n_in != 20 || in_sizes[0] != ML * D || out_size != ML * D || ws_size < WS_END) {
            fprintf(stderr, "kernel_launch: unexpected shapes: n_in %d in0 %d out %d ws %zu (need %zu)\n", n_in, n_in > 0 ? in_sizes[0] : -1, out_size, ws_size, (size_t)WS_END); grid = -1; return; }
        int dev = 0, cus = 0, per_cu = 0;
        if (hipGetDevice(&dev) != hipSuccess || hipDeviceGetAttribute(&cus, hipDeviceAttributeMultiprocessorCount, dev) != hipSuccess) { grid = -1; return; }
        if (hipFuncSetAttribute((const void*)mk_fwd, hipFuncAttributeMaxDynamicSharedMemorySize, LDS_BYTES) != hipSuccess) { fprintf(stderr, "kernel_launch: hipFuncSetAttribute failed\n"); grid = -1; return; }
        if (hipOccupancyMaxActiveBlocksPerMultiprocessor(&per_cu, (const void*)mk_fwd, NWAVES * 64, LDS_BYTES) != hipSuccess || per_cu < 1) {
            fprintf(stderr, "kernel_launch: occupancy query reports %d workgroups per CU\n", per_cu); (void)hipGetLastError(); grid = -1; return; }
        grid = cus < 256 ? cus : 256;
    }
    if (grid < 0) return;
    if (hipMemsetAsync((char*)d_ws + WS_CTL, 0, CTL_ZERO_BYTES, stream) != hipSuccess) return;
    Args a{};
    for (int i = 0; i < 20; ++i) a.in[i] = (const float*)d_in[i];
    a.out = (float*)d_out; a.ws = (unsigned char*)d_ws;
#if MK_PER_PHASE
    for (int ph = 0; ph < N_PHASES; ++ph) { a.ph_lo = ph; a.ph_hi = ph + 1; hipLaunchKernelGGL(mk_fwd, dim3(grid), dim3(NWAVES * 64), LDS_BYTES, stream, a); }
#else
    a.ph_lo = 0; a.ph_hi = N_PHASES;
    hipLaunchKernelGGL(mk_fwd, dim3(grid), dim3(NWAVES * 64), LDS_BYTES, stream, a);
#endif
    const hipError_t le = hipPeekAtLastError();
    if (le != hipSuccess) fprintf(stderr, "kernel_launch: launch failed: %s\n", hipGetErrorName(le));
}
```
